# Optimizing an MI355X kernel written in HIP

```python
import math
import jax
import jax.numpy as jnp
from jax import lax
import numpy as np

D_MODEL = 2048
BATCH = 4
SEQ = 2048
DEPTH = 4
DEC_BATCH = 128
DEC_SEQ = 8
PAST_LEN = 16384
PAGE_SIZE = 128

SSM_GROUP = 16
SSM_WIDTH = D_MODEL // 2
SSM_GROUPS = SSM_WIDTH // SSM_GROUP
SSM_STATE = 64
DT_MIN = 1e-3
DT_MAX = 1e-1
POOL_WINDOWS = (2, 4, 8, 16)
POOL_WIDTH = D_MODEL // 2
POOL_GROUP = POOL_WIDTH // len(POOL_WINDOWS)
POOL_BUF = max(POOL_WINDOWS) - 1
D_FF = 5632
PLE_DIM = 256
IN_WIDTH = SSM_WIDTH + POOL_WIDTH + 2 * D_MODEL
RMS_EPS = 1e-6

kernel_name = 'hybrid_s5_pool_gated_decoder_step'


def _rmsnorm(x, g):
    x32 = x.astype(jnp.float32)
    y = x32 * lax.rsqrt(jnp.mean(x32 * x32, axis=-1, keepdims=True) + RMS_EPS)
    return y.astype(x.dtype) * g


def _swiglu(x, w_gate, w_up, w_down):
    return (jax.nn.silu(x @ w_gate) * (x @ w_up)) @ w_down


def _cmul(ar, ai, br, bi):
    return ar * br - ai * bi, ar * bi + ai * br


def _scan_combine(e1, e2):
    a1r, a1i, b1r, b1i = e1
    a2r, a2i, b2r, b2i = e2
    ar, ai = _cmul(a2r, a2i, a1r, a1i)
    br, bi = _cmul(a2r, a2i, b1r, b1i)
    return ar, ai, br + b2r, bi + b2i


def _s5(u, s0_re, s0_im, a_re, a_im, log_dt, b_re, b_im, c_re, c_im, d):
    f32 = jnp.float32
    n, l, _ = u.shape
    uf = u.astype(f32).reshape(n, l, SSM_GROUPS, SSM_GROUP)
    a_re = a_re.astype(f32)
    a_im = a_im.astype(f32)
    dt = jnp.exp(log_dt.astype(f32))[:, None]
    mag = jnp.exp(a_re * dt)
    ang = a_im * dt
    lam_re = mag * jnp.cos(ang)
    lam_im = mag * jnp.sin(ang)
    den = a_re * a_re + a_im * a_im
    num_re = lam_re - 1.0
    k_re = (num_re * a_re + lam_im * a_im) / den
    k_im = (lam_im * a_re - num_re * a_im) / den
    bb_re, bb_im = _cmul(k_re[..., None], k_im[..., None], b_re.astype(f32), b_im.astype(f32))
    x_re = jnp.einsum('nlgh,gph->nlgp', uf, bb_re)
    x_im = jnp.einsum('nlgh,gph->nlgp', uf, bb_im)
    c0_re, c0_im = _cmul(lam_re, lam_im, s0_re.astype(f32), s0_im.astype(f32))
    x_re = x_re.at[:, 0].add(c0_re)
    x_im = x_im.at[:, 0].add(c0_im)
    lr = jnp.broadcast_to(lam_re, x_re.shape)
    li = jnp.broadcast_to(lam_im, x_re.shape)
    _, _, s_re, s_im = lax.associative_scan(_scan_combine, (lr, li, x_re, x_im), axis=1)
    y = (jnp.einsum('nlgp,ghp->nlgh', s_re, c_re.astype(f32))
         - jnp.einsum('nlgp,ghp->nlgh', s_im, c_im.astype(f32))
         + d.astype(f32) * uf)
    return (y.reshape(n, l, SSM_WIDTH).astype(u.dtype),
            s_re[:, -1].astype(u.dtype), s_im[:, -1].astype(u.dtype))


def _pool(u, prev, pos0, w_pool, pool_scale):
    f32 = jnp.float32
    n, l, _ = u.shape
    z = jnp.concatenate([prev.astype(u.dtype), u], axis=1).astype(f32)
    cs = jnp.pad(jnp.cumsum(z, axis=1), ((0, 0), (1, 0), (0, 0)))
    pos = pos0 + jnp.arange(l)
    cur = z[:, POOL_BUF:]
    means = []
    for gi, w in enumerate(POOL_WINDOWS):
        c0, c1 = gi * POOL_GROUP, (gi + 1) * POOL_GROUP
        win = (cs[:, POOL_BUF + 1:POOL_BUF + 1 + l, c0:c1]
               - cs[:, POOL_BUF + 1 - w:POOL_BUF + 1 - w + l, c0:c1])
        cnt = jnp.minimum(pos + 1, w).astype(f32)[None, :, None]
        means.append(win / cnt)
    mixed = (jnp.concatenate(means, axis=-1) - cur).reshape(n, l, len(POOL_WINDOWS), POOL_GROUP)
    mixed = jnp.einsum('nlgc,gcd->nlgd', mixed, w_pool.astype(f32)).reshape(n, l, POOL_WIDTH)
    out = mixed * pool_scale.astype(f32)
    return out.astype(u.dtype), z[:, -POOL_BUF:].astype(u.dtype)


def _layer(x, p_i, s_re, s_im, pool_prev, pos0, prm, i):
    h = x + 0.5 * _swiglu(_rmsnorm(x, prm['g_ffn1'][i]), prm['w_ffn1_gate'][i],
                          prm['w_ffn1_up'][i], prm['w_ffn1_down'][i])
    proj = _rmsnorm(h, prm['g_mix'][i]) @ prm['w_in'][i]
    o1 = SSM_WIDTH
    o2 = o1 + POOL_WIDTH
    o3 = o2 + D_MODEL
    u_a, u_b, gate_a, gate_b = proj[..., :o1], proj[..., o1:o2], proj[..., o2:o3], proj[..., o3:]
    y_a, s_re_new, s_im_new = _s5(u_a, s_re, s_im, prm['ssm_a_re'][i], prm['ssm_a_im'][i],
                                  prm['ssm_log_dt'][i], prm['ssm_b_re'][i], prm['ssm_b_im'][i],
                                  prm['ssm_c_re'][i], prm['ssm_c_im'][i], prm['ssm_d'][i])
    y_a = jax.nn.gelu(y_a)
    br_a = (y_a @ prm['w_glu_a'][i]) * jax.nn.sigmoid(y_a @ prm['w_glu_b'][i])
    y_b, pool_new = _pool(u_b, pool_prev, pos0, prm['w_pool'][i], prm['pool_scale'][i])
    br_b = y_b @ prm['w_pool_up'][i]
    merged = jax.nn.sigmoid(gate_a) * br_a + jax.nn.sigmoid(gate_b) * br_b
    h = h + merged @ prm['w_out'][i]
    h = h + 0.5 * _swiglu(_rmsnorm(h, prm['g_ffn2'][i]), prm['w_ffn2_gate'][i],
                          prm['w_ffn2_up'][i], prm['w_ffn2_down'][i])
    h = h + (p_i @ prm['w_ple'][i]) * jax.nn.sigmoid(_rmsnorm(h, prm['g_ple'][i]) @ prm['w_ple_gate'][i])
    return h, s_re_new, s_im_new, pool_new


def _trunk(x, p, s_re, s_im, pool, pos0, prm):
    new_re, new_im, new_pool = [], [], []
    for i in range(DEPTH):
        x, r, m, q = _layer(x, p[i], s_re[i], s_im[i], pool[i], pos0, prm, i)
        new_re.append(r)
        new_im.append(m)
        new_pool.append(q)
    return _rmsnorm(x, prm['g_final']), jnp.stack(new_re), jnp.stack(new_im), jnp.stack(new_pool)


def setup_inputs(seed: int = 0) -> dict:
    key = jax.random.key(seed)
    ks = iter(jax.random.split(key, 48))
    f32 = jnp.float32

    def nrm(shape, scale):
        return jax.random.normal(next(ks), shape, f32) * scale

    def gain(shape):
        return 1.0 + nrm(shape, 0.05)

    G, P, H = SSM_GROUPS, SSM_STATE, SSM_GROUP
    inp = {}
    inp['x_prompt'] = nrm((BATCH, SEQ, D_MODEL), 1.0)
    inp['x_sample'] = nrm((DEC_BATCH, DEC_SEQ, D_MODEL), 1.0)
    inp['state_ssm_re'] = nrm((DEPTH, DEC_BATCH, G, P), 0.1)
    inp['state_ssm_im'] = nrm((DEPTH, DEC_BATCH, G, P), 0.1)
    inp['state_pool'] = nrm((DEPTH, DEC_BATCH, POOL_BUF, POOL_WIDTH), 1.0)
    inp['p_prompt'] = nrm((DEPTH, BATCH, SEQ, PLE_DIM), 1.0)
    inp['p_sample'] = nrm((DEPTH, DEC_BATCH, DEC_SEQ, PLE_DIM), 1.0)
    inp['g_ffn1'] = gain((DEPTH, D_MODEL))
    inp['w_ffn1_gate'] = nrm((DEPTH, D_MODEL, D_FF), D_MODEL ** -0.5)
    inp['w_ffn1_up'] = nrm((DEPTH, D_MODEL, D_FF), D_MODEL ** -0.5)
    inp['w_ffn1_down'] = nrm((DEPTH, D_FF, D_MODEL), D_FF ** -0.5)
    inp['g_mix'] = gain((DEPTH, D_MODEL))
    inp['w_in'] = nrm((DEPTH, D_MODEL, IN_WIDTH), D_MODEL ** -0.5)
    inp['ssm_a_re'] = -0.5 + nrm((DEPTH, G, P), 0.01)
    inp['ssm_a_im'] = jnp.broadcast_to(math.pi * jnp.arange(P, dtype=f32), (DEPTH, G, P)) + nrm((DEPTH, G, P), 0.01)
    inp['ssm_log_dt'] = jax.random.uniform(next(ks), (DEPTH, G), f32, math.log(DT_MIN), math.log(DT_MAX))
    inp['ssm_b_re'] = nrm((DEPTH, G, P, H), (2 * H) ** -0.5)
    inp['ssm_b_im'] = nrm((DEPTH, G, P, H), (2 * H) ** -0.5)
    inp['ssm_c_re'] = nrm((DEPTH, G, H, P), P ** -0.5)
    inp['ssm_c_im'] = nrm((DEPTH, G, H, P), P ** -0.5)
    inp['ssm_d'] = nrm((DEPTH, G, H), 1.0)
    inp['w_glu_a'] = nrm((DEPTH, SSM_WIDTH, D_MODEL), SSM_WIDTH ** -0.5)
    inp['w_glu_b'] = nrm((DEPTH, SSM_WIDTH, D_MODEL), SSM_WIDTH ** -0.5)
    inp['w_pool'] = nrm((DEPTH, len(POOL_WINDOWS), POOL_GROUP, POOL_GROUP), POOL_GROUP ** -0.5)
    inp['pool_scale'] = gain((DEPTH, POOL_WIDTH))
    inp['w_pool_up'] = nrm((DEPTH, POOL_WIDTH, D_MODEL), POOL_WIDTH ** -0.5)
    inp['w_out'] = nrm((DEPTH, D_MODEL, D_MODEL), D_MODEL ** -0.5)
    inp['g_ffn2'] = gain((DEPTH, D_MODEL))
    inp['w_ffn2_gate'] = nrm((DEPTH, D_MODEL, D_FF), D_MODEL ** -0.5)
    inp['w_ffn2_up'] = nrm((DEPTH, D_MODEL, D_FF), D_MODEL ** -0.5)
    inp['w_ffn2_down'] = nrm((DEPTH, D_FF, D_MODEL), D_FF ** -0.5)
    inp['g_ple'] = gain((DEPTH, D_MODEL))
    inp['w_ple'] = nrm((DEPTH, PLE_DIM, D_MODEL), PLE_DIM ** -0.5)
    inp['w_ple_gate'] = nrm((DEPTH, D_MODEL, D_MODEL), D_MODEL ** -0.5)
    inp['g_final'] = gain((D_MODEL,))
    return inp


def reference(x_prompt, x_sample, state_ssm_re, state_ssm_im, state_pool, p_prompt, p_sample,
              g_ffn1, w_ffn1_gate, w_ffn1_up, w_ffn1_down, g_mix, w_in,
              ssm_a_re, ssm_a_im, ssm_log_dt, ssm_b_re, ssm_b_im, ssm_c_re, ssm_c_im, ssm_d,
              w_glu_a, w_glu_b, w_pool, pool_scale, w_pool_up, w_out,
              g_ffn2, w_ffn2_gate, w_ffn2_up, w_ffn2_down, g_ple, w_ple, w_ple_gate, g_final):
    prm = dict(g_ffn1=g_ffn1, w_ffn1_gate=w_ffn1_gate, w_ffn1_up=w_ffn1_up, w_ffn1_down=w_ffn1_down,
               g_mix=g_mix, w_in=w_in, ssm_a_re=ssm_a_re, ssm_a_im=ssm_a_im, ssm_log_dt=ssm_log_dt,
               ssm_b_re=ssm_b_re, ssm_b_im=ssm_b_im, ssm_c_re=ssm_c_re, ssm_c_im=ssm_c_im, ssm_d=ssm_d,
               w_glu_a=w_glu_a, w_glu_b=w_glu_b, w_pool=w_pool, pool_scale=pool_scale,
               w_pool_up=w_pool_up, w_out=w_out, g_ffn2=g_ffn2, w_ffn2_gate=w_ffn2_gate,
               w_ffn2_up=w_ffn2_up, w_ffn2_down=w_ffn2_down, g_ple=g_ple, w_ple=w_ple,
               w_ple_gate=w_ple_gate, g_final=g_final)
    zero_ssm = jnp.zeros((DEPTH, BATCH, SSM_GROUPS, SSM_STATE), x_prompt.dtype)
    zero_pool = jnp.zeros((DEPTH, BATCH, POOL_BUF, POOL_WIDTH), x_prompt.dtype)
    y_prompt, ssm_re_prompt, ssm_im_prompt, pool_prompt = _trunk(
        x_prompt, p_prompt, zero_ssm, zero_ssm, zero_pool, 0, prm)
    y_sample, ssm_re_sample, ssm_im_sample, pool_sample = _trunk(
        x_sample, p_sample, state_ssm_re, state_ssm_im, state_pool, PAST_LEN, prm)
    return (y_prompt, y_sample, ssm_re_prompt, ssm_im_prompt, pool_prompt,
            ssm_re_sample, ssm_im_sample, pool_sample)
```

```cpp
#include <hip/hip_runtime.h>
#include <cstdio>

#ifndef MK_ONE_LAUNCH
#define MK_ONE_LAUNCH 1
#endif

#define GAS __attribute__((address_space(1)))
#define LAS __attribute__((address_space(3)))
typedef unsigned short bf16_t;
typedef short bf16x8 __attribute__((ext_vector_type(8)));
typedef float f32x4 __attribute__((ext_vector_type(4)));
typedef float f32x2 __attribute__((ext_vector_type(2)));
typedef float f32x16 __attribute__((ext_vector_type(16)));
typedef unsigned u32x4 __attribute__((ext_vector_type(4)));
typedef unsigned u32x2 __attribute__((ext_vector_type(2)));
typedef GAS unsigned gu32;
#define RLX_AGENT __ATOMIC_RELAXED, __HIP_MEMORY_SCOPE_AGENT
#define LDS_WAIT() asm volatile("s_waitcnt lgkmcnt(0)" ::: "memory")
#define VM_WAIT() asm volatile("s_waitcnt vmcnt(0)" ::: "memory")

constexpr int D = 2048, FF = 5632, NIN = 6144, DEPTH = 4;
constexpr int SEQ = 2048, NB = 4, DB = 128, DS = 8;
constexpr int MP = NB * SEQ, MS = DB * DS, M = MP + MS;
constexpr int SW = 1024, PW = 1024, NG = 64, NP = 64, NH = 16, PLE = 256, PBUF = 15;
constexpr float RMS_EPS = 1e-6f;
constexpr int NWAVES = 8, NTHREADS = 512;

enum { I_XP = 0, I_XS, I_SRE, I_SIM, I_SPOOL, I_PP, I_PS, I_GF1, I_WG1, I_WU1, I_WD1, I_GMIX, I_WIN, I_ARE, I_AIM, I_LDT, I_BRE, I_BIM, I_CRE, I_CIM, I_SD,
       I_GLA, I_GLB, I_WPOOL, I_PSCALE, I_WPU, I_WOUT, I_GF2, I_WG2, I_WU2, I_WD2, I_GPLE, I_WPLE, I_WPG, I_GFIN, N_IN };
constexpr size_t O_Y = 0, O_SRP = (size_t)M * D, O_SIP = O_SRP + 65536, O_PP = O_SIP + 65536, O_SRS = O_PP + 245760, O_SIS = O_SRS + 2097152, O_PS = O_SIS + 2097152,
                 O_END = O_PS + 7864320;

constexpr size_t MiB = 1u << 20;
constexpr size_t WS_CTL = 0, CTL_ZERO_BYTES = 14 * 16384;
constexpr size_t WO_GU1 = 0, WO_D1 = WO_GU1 + (size_t)2 * FF * D * 2, WO_IN = WO_D1 + (size_t)D * FF * 2, WO_GLU = WO_IN + (size_t)NIN * D * 2,
                 WO_PU = WO_GLU + (size_t)2 * D * SW * 2, WO_EFF = WO_PU + (size_t)D * PW * 2, WO_OUT = WO_EFF + (size_t)D * PW * 2, WO_GU2 = WO_OUT + (size_t)D * D * 2,
                 WO_D2 = WO_GU2 + (size_t)2 * FF * D * 2, WO_PG = WO_D2 + (size_t)D * FF * 2, WO_PLE = WO_PG + (size_t)D * D * 2, WO_POOL = WO_PLE + (size_t)D * PLE * 2,
                 WL = WO_POOL + (size_t)4 * 256 * 256 * 2;
constexpr size_t WS_W = 1 * MiB;
constexpr size_t WS_H = WS_W + DEPTH * WL;
constexpr size_t WS_HB0 = WS_H + (size_t)M * D * 4, WS_HB1 = WS_HB0 + (size_t)M * D * 2;
constexpr size_t WS_ACT = WS_HB1 + (size_t)M * D * 2;
constexpr size_t WS_UA = WS_ACT + (size_t)M * FF * 2, WS_UB = WS_UA + (size_t)M * SW * 2;
constexpr size_t WS_SGA = WS_UB + (size_t)M * PW * 2, WS_SGB = WS_SGA + (size_t)M * D * 2;
constexpr size_t WS_YA = WS_SGB + (size_t)M * D * 2, WS_MIX = WS_YA + (size_t)M * SW * 2;
constexpr size_t WS_PART = WS_MIX + (size_t)M * PW * 2, WS_MRG = WS_PART + (size_t)M * D * 2, WS_T1 = WS_MRG + (size_t)M * D * 2;
constexpr size_t WS_PB = WS_T1 + (size_t)M * D * 2;
constexpr size_t WS_SSQ = WS_PB + (size_t)DEPTH * M * PLE * 2;
constexpr size_t WS_END = WS_SSQ + (size_t)2 * M * 32 * 4;
static_assert(WL % 256 == 0 && WS_H % 256 == 0 && WS_SSQ % 256 == 0, "alignment");
constexpr int CW_BAR = 0;

constexpr int RING_BYTES = 131072, XS_OFF = RING_BYTES, XS_BYTES = 16384;
constexpr int LDSCTL_OFF = XS_OFF + XS_BYTES, MISC_OFF = LDSCTL_OFF + 320, LDS_BYTES = LDSCTL_OFF + 1024;

__device__ __forceinline__ int lane_id() { return (int)__builtin_amdgcn_mbcnt_hi(~0u, __builtin_amdgcn_mbcnt_lo(~0u, 0u)); }
#define TID_FROM(wv) ((wv) * 64 + lane_id())
typedef __bf16 bf16x2_t __attribute__((ext_vector_type(2)));
__device__ __forceinline__ unsigned cvt_pk_bf16(float lo, float hi) { const f32x2 v = {lo, hi}; return __builtin_bit_cast(unsigned, __builtin_convertvector(v, bf16x2_t)); }
__device__ __forceinline__ float bf_lo(unsigned w) { return __uint_as_float(w << 16); }
__device__ __forceinline__ float bf_hi(unsigned w) { return __uint_as_float(w & 0xffff0000u); }
__device__ __forceinline__ float sigmoid_f(float x) { return __builtin_amdgcn_rcpf(1.0f + __expf(-x)); }
__device__ __forceinline__ float wave_sum(float v) {
#pragma unroll
    for (int o = 1; o < 64; o <<= 1) v += __shfl_xor(v, o);
    return v;
}
struct SsqRegs { f32x4 a, b; };
__device__ __forceinline__ void ssq_load(const float* ssq, int row, int fq, SsqRegs& R) { const f32x4* p = (const f32x4*)(ssq + (size_t)row * 32 + 8 * fq); R.a = p[0]; R.b = p[1]; }
__device__ __forceinline__ float msq_from(const SsqRegs& R) {
    float s = ((R.a.x + R.a.y) + (R.a.z + R.a.w)) + ((R.b.x + R.b.y) + (R.b.z + R.b.w));
    s += __shfl_xor(s, 16); s += __shfl_xor(s, 32);
    return s * (1.0f / D) + RMS_EPS;
}
__device__ __forceinline__ f32x4 sigk4(const f32x4 t, const float kinv) {
    f32x4 e;
#pragma unroll
    for (int j = 0; j < 4; ++j) e[j] = __builtin_amdgcn_exp2f(t[j]);
    e = e * kinv + kinv;
#pragma unroll
    for (int j = 0; j < 4; ++j) e[j] = __builtin_amdgcn_rcpf(e[j]);
    return e;
}
__device__ __forceinline__ float rstd_from(const SsqRegs& R) {
    float s = ((R.a.x + R.a.y) + (R.a.z + R.a.w)) + ((R.b.x + R.b.y) + (R.b.z + R.b.w));
    s += __shfl_xor(s, 16); s += __shfl_xor(s, 32);
    return __builtin_amdgcn_rsqf(s * (1.0f / D) + RMS_EPS);
}

namespace pg8 {
constexpr int BM = 256, BK = 64, HALF = 128, HTB = HALF * BK * 2, STAGE_BYTES = 8 * HTB, NXCD = 8, WGM = 4;
__host__ __device__ __forceinline__ int lds_byte(int r, int c) { const int st = (r >> 4) * 2 + (c >> 5), rr = r & 15, cc = c & 31, ob = rr * 64 + cc * 2; return st * 1024 + (ob ^ (((ob >> 9) & 1) << 5)); }
__host__ __device__ __forceinline__ void stage_rc(int b, int& R, int& C) { const int st = b / 1024, sb = b % 1024, swz = sb ^ (((sb >> 9) & 1) << 5); R = (st >> 1) * 16 + swz / 64; C = (st & 1) * 32 + (swz % 64) / 2; }
__host__ __device__ __forceinline__ int perm32(int rho) { const int n = rho >> 4, i = rho & 15; return 8 * (i >> 2) + 4 * n + (i & 3); }

struct Unit { int pm, pn; unsigned aoff, boff, xoff; };
struct Gemm { const bf16_t* A; const bf16_t* Bt; int lda, ldb, K; const unsigned char* ws; };

struct StaticOrder {
    int nM, nN, nwg, G, c; unsigned ta, tb, tx, x0;
    __device__ void init(int Mrows, int N, int lda, int ldb, int G_, int c_) { nM = Mrows / BM; nN = N / BM; nwg = nM * nN; G = G_; c = c_; ta = (unsigned)BM * lda * 2u; tb = (unsigned)BM * ldb * 2u; tx = 32u * lda * 2u; x0 = (unsigned)MP * lda * 2u; }
    __device__ __forceinline__ bool next(int i, Unit& u) const {
        const long L = (long)i * G + c; if (L >= nwg) return false;
        int wgid = (int)L; { const int q = nwg / NXCD, r = nwg % NXCD, xcd = wgid % NXCD, off = wgid / NXCD; wgid = (xcd < r ? xcd * (q + 1) : r * (q + 1) + (xcd - r) * q) + off; }
        const int nig = WGM * nN, gid = wgid / nig, fm = gid * WGM, gsz = (nM - fm) < WGM ? (nM - fm) : WGM;
        u.pm = fm + ((wgid % nig) % gsz); u.pn = (wgid % nig) / gsz;
        u.aoff = (unsigned)u.pm * ta; u.boff = (unsigned)u.pn * tb; u.xoff = x0 + (unsigned)u.pm * tx; return true;
    }
};

struct NoExtra { __device__ __forceinline__ void after_unit(int, int, int) const {} };
struct NoPre { __device__ __forceinline__ void top() const {} __device__ __forceinline__ void rest() const {} };
template <class Epi, class Sched, bool XT, class Pre = NoPre, class Extra = NoExtra, bool ALIGN_EPI = true>
__device__ __forceinline__ void gemm_phase(LAS unsigned char* lds, const Gemm g, const Sched& S, const Epi& E, int wv, const Pre& P = Pre(), const Extra& X = Extra()) {
    asm volatile("" : "+s"(wv));
    int tid = TID_FROM(wv); asm volatile("" : "+v"(tid));
    const int wid = wv, lane = tid & 63, wr = wid >> 2, wc = wid & 3, fr = lane & 15, fq = lane >> 4;
    int K = g.K; asm volatile("" : "+s"(K));
    const int nt = K / BK;
    unsigned voffA, voffB;
    { int R, C; stage_rc(tid * 16, R, C); const int Rb = (R & ~31) + perm32(R & 31); voffA = (unsigned)(R * g.lda + C) * 2u; voffB = (unsigned)(Rb * g.ldb + C) * 2u; }
    const unsigned q_voffA = 64u * g.lda * 2u, q_voffB = 64u * g.ldb * 2u;
    const __amdgpu_buffer_rsrc_t rs = __builtin_amdgcn_make_buffer_rsrc((void*)g.ws, 0, (int)WS_END, 0x00020000);
    const unsigned oA = (unsigned)((const unsigned char*)g.A - g.ws), oB = (unsigned)((const unsigned char*)g.Bt - g.ws);
    const unsigned kstep = (unsigned)(BK * 2);
    const unsigned hstepA = (unsigned)HALF * g.lda * 2u, hstepB = (unsigned)HALF * g.ldb * 2u;
    const unsigned ldsw = (unsigned)wid * 1024u;
    const int aoff = lds_byte(wr * 64 + fr, fq * 8), boff = lds_byte(wc * 32 + fr, fq * 8);
    const int xadj = wr * (128 - 64 * g.lda); const unsigned xdst = XS_OFF + 8192u * ((wid >> 1) & 1) + 2048u * (wid >> 2) + 1024u * (wid & 1);
#define PG8_SA(b, h) (((b) * 2 + (h)) * HTB)
#define PG8_SB(b, h) ((4 + (b) * 2 + (h)) * HTB)
#define PG8_STAGE2(bufoff, gbase, voff, q) do { \
        __builtin_amdgcn_raw_ptr_buffer_load_lds(rs, (LAS unsigned*)(lds + (bufoff) + ldsw), 16, (int)(voff), (int)(gbase), 0, 0); \
        __builtin_amdgcn_raw_ptr_buffer_load_lds(rs, (LAS unsigned*)(lds + (bufoff) + ldsw + 8192), 16, (int)(voff), (int)((gbase) + (q)), 0, 0); } while (0)
#define PG8_STAGE(bufoff, gbase, voff) PG8_STAGE2(bufoff, gbase, voff, q_##voff)
#define PG8_STAGEX(slot, gbase) do { if constexpr (XT) __builtin_amdgcn_raw_ptr_buffer_load_lds(rs, (LAS unsigned*)(lds + xdst + (slot) * 4096), 16, (int)voffA, (int)(gbase) + xadj, 0, 0); } while (0)
#define PG8_LDA(dst, b, h) do { _Pragma("unroll") for (int m = 0; m < 4; ++m) _Pragma("unroll") for (int k = 0; k < 2; ++k) dst[m][k] = *(const LAS bf16x8*)(lds + PG8_SA(b, h) + aoff + m * 2048 + k * 1024); } while (0)
#define PG8_LDB(dst, b, h) do { _Pragma("unroll") for (int n = 0; n < 2; ++n) _Pragma("unroll") for (int k = 0; k < 2; ++k) dst[n][k] = *(const LAS bf16x8*)(lds + PG8_SB(b, h) + boff + n * 2048 + k * 1024); } while (0)
#define PG8_LDX(slot, kh) do { if constexpr (XT) { _Pragma("unroll") for (int k = 0; k < 2; ++k) Xf[k] = *(const LAS bf16x8*)(lds + XS_OFF + aoff + (slot) * 4096 + (kh) * 2048 + k * 1024); } } while (0)
#define PG8_MMA(ai, bj, At, Bt) do { _Pragma("unroll") for (int m = 0; m < 4; ++m) _Pragma("unroll") for (int n = 0; n < 2; ++n) _Pragma("unroll") for (int k = 0; k < 2; ++k) \
        acc[ai][bj][m][n] = __builtin_amdgcn_mfma_f32_16x16x32_bf16(Bt[n][k], At[m][k], acc[ai][bj][m][n], 0, 0, 0); } while (0)
#define PG8_MMAX() do { if constexpr (XT) { _Pragma("unroll") for (int n = 0; n < 2; ++n) _Pragma("unroll") for (int k = 0; k < 2; ++k) { \
        accx[0][n] = __builtin_amdgcn_mfma_f32_16x16x32_bf16(B0[n][k], Xf[k], accx[0][n], 0, 0, 0); accx[1][n] = __builtin_amdgcn_mfma_f32_16x16x32_bf16(B1[n][k], Xf[k], accx[1][n], 0, 0, 0); } } } while (0)
#define PG8_WAIT_V(n) asm volatile("s_waitcnt vmcnt(" #n ")" ::: "memory")
#define PG8_WAIT_VX(nx, n) do { if constexpr (XT) PG8_WAIT_V(nx); else PG8_WAIT_V(n); } while (0)
#define PG8_WAIT_L(n) asm volatile("s_waitcnt lgkmcnt(" #n ")" ::: "memory")
#define PG8_BAR __builtin_amdgcn_s_barrier()
#define PG8_SCHED __builtin_amdgcn_sched_barrier(0)
#define PG8_PRIO(p) __builtin_amdgcn_s_setprio(p)
    Unit cur, nxt; int ui = 0;
    if (!S.next(0, cur)) { P.top(); P.rest(); return; }
    f32x4 acc[2][2][4][2], accx[2][2];
#pragma unroll
    for (int a = 0; a < 2; ++a)
#pragma unroll
        for (int b = 0; b < 2; ++b) {
#pragma unroll
            for (int m = 0; m < 4; ++m)
#pragma unroll
                for (int n = 0; n < 2; ++n) acc[a][b][m][n] = (f32x4){0.f, 0.f, 0.f, 0.f};
            accx[a][b] = (f32x4){0.f, 0.f, 0.f, 0.f}; }
    bf16x8 At[4][2], B0[2][2], B1[2][2], Xf[2];
    unsigned cA = oA + cur.aoff, cB = oB + cur.boff, cX = oA + cur.xoff;
    int xs = 0;
    P.top();
    PG8_STAGE(PG8_SB(0, 0), cB, voffB); PG8_STAGE(PG8_SB(0, 1), cB + hstepB, voffB);
    P.rest();
    PG8_STAGEX(0, cX);
    PG8_STAGE(PG8_SA(0, 0), cA, voffA); PG8_STAGE(PG8_SA(0, 1), cA + hstepA, voffA);
    if (wr == 1) PG8_BAR;
    PG8_WAIT_V(2); PG8_BAR;
    PG8_STAGE(PG8_SB(1, 0), cB + kstep, voffB); PG8_STAGE(PG8_SA(1, 0), cA + kstep, voffA); PG8_STAGE(PG8_SB(1, 1), cB + hstepB + kstep, voffB);
    PG8_WAIT_V(6); PG8_BAR;
    for (;;) {
        const bool has_next = S.next(ui + 1, nxt);
        const unsigned nA = has_next ? oA + nxt.aoff : cA, nB = has_next ? oB + nxt.boff : cB, nX = has_next ? oA + nxt.xoff : cX;
        for (int t = 0; t < nt; t += 2) {
            const bool last = (t == nt - 2);
            const unsigned a1 = cA + (unsigned)(t + 1) * kstep;
            const unsigned a2 = last ? nA : cA + (unsigned)(t + 2) * kstep, b2 = last ? nB : cB + (unsigned)(t + 2) * kstep, x2 = last ? nX : cX + (unsigned)(t + 2) * kstep;
            const unsigned a3 = a2 + kstep, b3 = b2 + kstep;
            PG8_LDB(B0, 0, 0); PG8_LDB(B1, 0, 1); PG8_SCHED; PG8_LDA(At, 0, 0); PG8_LDX(xs, 0); PG8_STAGEX(xs ^ 1, x2); PG8_STAGE(PG8_SA(1, 1), a1 + hstepA, voffA);
            PG8_WAIT_VX(9, 8); PG8_WAIT_L(0); PG8_BAR; PG8_PRIO(1); PG8_MMA(0, 0, At, B0); PG8_MMA(0, 1, At, B1); PG8_MMAX(); PG8_PRIO(0); PG8_BAR; PG8_SCHED;
            PG8_LDA(At, 0, 1); PG8_STAGE(PG8_SB(0, 0), b2, voffB); PG8_STAGE(PG8_SB(0, 1), b2 + hstepB, voffB); PG8_STAGE(PG8_SA(0, 0), a2, voffA);
            PG8_WAIT_VX(9, 8); PG8_WAIT_L(0); PG8_BAR; PG8_PRIO(1); PG8_MMA(1, 0, At, B0); PG8_MMA(1, 1, At, B1); PG8_PRIO(0); PG8_BAR; PG8_SCHED;
            PG8_LDB(B0, 1, 0); PG8_LDB(B1, 1, 1); PG8_SCHED; PG8_LDA(At, 1, 0); PG8_LDX(xs, 1); PG8_STAGE(PG8_SA(0, 1), a2 + hstepA, voffA);
            PG8_WAIT_V(8); PG8_WAIT_L(0); PG8_BAR; PG8_PRIO(1); PG8_MMA(0, 0, At, B0); PG8_MMA(0, 1, At, B1); PG8_MMAX(); PG8_PRIO(0); PG8_BAR; PG8_SCHED;
            PG8_LDA(At, 1, 1); PG8_STAGE(PG8_SB(1, 0), b3, voffB); PG8_STAGE(PG8_SB(1, 1), b3 + hstepB, voffB); PG8_STAGE(PG8_SA(1, 0), a3, voffA);
            PG8_WAIT_V(8); PG8_WAIT_L(0); PG8_BAR; PG8_PRIO(1); PG8_MMA(1, 0, At, B0); PG8_MMA(1, 1, At, B1); PG8_PRIO(0); PG8_BAR; PG8_SCHED;
            xs ^= 1;
        }
        if constexpr (ALIGN_EPI) { if (wr == 0) PG8_BAR; }
        {
            asm volatile("s_nop 15\n\ts_nop 15\n\ts_nop 15\n\ts_nop 15" ::: "memory");
            int lz = lane_id(); asm volatile("" : "+v"(lz)); const int fr2 = lz & 15, fq2 = lz >> 4;
            constexpr int NR = XT ? 9 : 8, BT = Epi::BATCH;
#pragma unroll
            for (int r0 = 0; r0 < NR; r0 += BT) {
                typename Epi::Regs R[BT];
#pragma unroll
                for (int b = 0; b < BT; ++b) if (r0 + b < NR) { const int r = r0 + b; E.load(r < 8 ? cur.pm * BM + (r >> 2) * HALF + wr * 64 + (r & 3) * 16 + fr2 : MP + 32 * cur.pm + wr * 16 + fr2, cur, wc, fq2, R[b]); }
                if (Epi::HAS_LOADS) asm volatile("s_waitcnt vmcnt(0)" ::: "memory");
#pragma unroll
                for (int b = 0; b < BT; ++b) if (r0 + b < NR) { const int r = r0 + b; const int row = r < 8 ? cur.pm * BM + (r >> 2) * HALF + wr * 64 + (r & 3) * 16 + fr2 : MP + 32 * cur.pm + wr * 16 + fr2;
                    if (r < 8) E.fin(acc[r >> 2][0][r & 3][0], acc[r >> 2][0][r & 3][1], acc[r >> 2][1][r & 3][0], acc[r >> 2][1][r & 3][1], row, cur, wc, fq2, R[b]);
                    else E.fin(accx[0][0], accx[0][1], accx[1][0], accx[1][1], row, cur, wc, fq2, R[b]); }
            }
        }
        X.after_unit(ui, wid, lane_id());
        if (!has_next) break;
#pragma unroll
        for (int a = 0; a < 2; ++a)
#pragma unroll
            for (int b = 0; b < 2; ++b) {
#pragma unroll
                for (int m = 0; m < 4; ++m)
#pragma unroll
                    for (int n = 0; n < 2; ++n) acc[a][b][m][n] = (f32x4){0.f, 0.f, 0.f, 0.f};
                accx[a][b] = (f32x4){0.f, 0.f, 0.f, 0.f}; }
        cur = nxt; cA = nA; cB = nB; cX = nX; ++ui;
        if constexpr (ALIGN_EPI) { if (wr == 1) PG8_BAR; }
    }
    PG8_WAIT_V(0);
    if constexpr (!ALIGN_EPI) { if (wr == 0) PG8_BAR; }
    PG8_BAR;
#undef PG8_SA
#undef PG8_SB
#undef PG8_STAGE
#undef PG8_STAGE2
#undef PG8_STAGEX
#undef PG8_LDA
#undef PG8_LDB
#undef PG8_LDX
#undef PG8_MMA
#undef PG8_MMAX
#undef PG8_WAIT_V
#undef PG8_WAIT_VX
#undef PG8_WAIT_L
#undef PG8_BAR
#undef PG8_SCHED
#undef PG8_PRIO
}
}

__device__ __forceinline__ u32x4 pack8(const f32x4 a, const f32x4 b) { u32x4 w; w.x = cvt_pk_bf16(a[0], a[1]); w.y = cvt_pk_bf16(a[2], a[3]); w.z = cvt_pk_bf16(b[0], b[1]); w.w = cvt_pk_bf16(b[2], b[3]); return w; }
__device__ __forceinline__ void unpack8(const u32x4 w, f32x4& a, f32x4& b) { a = (f32x4){bf_lo(w.x), bf_hi(w.x), bf_lo(w.y), bf_hi(w.y)}; b = (f32x4){bf_lo(w.z), bf_hi(w.z), bf_lo(w.w), bf_hi(w.w)}; }
__device__ __forceinline__ float sumsq8(const f32x4 a, const f32x4 b) { return ((a[0] * a[0] + a[1] * a[1]) + (a[2] * a[2] + a[3] * a[3])) + ((b[0] * b[0] + b[1] * b[1]) + (b[2] * b[2] + b[3] * b[3])); }

struct EpiGateUp {
    bf16_t* act; const float* ssq;
    typedef SsqRegs Regs; static constexpr int BATCH = 5; static constexpr bool HAS_LOADS = true;
    __device__ __forceinline__ void load(int row, const pg8::Unit&, int, int fq, Regs& R) const { ssq_load(ssq, row, fq, R); }
    __device__ __forceinline__ void fin(const f32x4 g0, const f32x4 g1, const f32x4 u0, const f32x4 u1, int row, const pg8::Unit& u, int wc, int fq, const Regs& R) const {
        const float m = msq_from(R), c = __builtin_amdgcn_rsqf(m) * -1.4426950408889634f;
        *(u32x4*)(act + (size_t)row * FF + u.pn * 128 + wc * 32 + 8 * fq) = pack8((g0 * u0) * sigk4(g0 * c, m), (g1 * u1) * sigk4(g1 * c, m));
    }
};
struct EpiResid {
    float* h; bf16_t* hb; float* ssq_out; float scale; const float* src_p; const float* src_s;
    struct Regs { f32x4 h0, h1, h2, h3; }; static constexpr int BATCH = 3; static constexpr bool HAS_LOADS = true;
    __device__ __forceinline__ void load(int row, const pg8::Unit& u, int wc, int fq, Regs& R) const {
        const float* hp = (row < MP ? src_p + (size_t)row * D : src_s + (size_t)(row - MP) * D) + u.pn * 256 + wc * 32 + 8 * fq; R.h0 = *(const f32x4*)hp; R.h1 = *(const f32x4*)(hp + 4); R.h2 = *(const f32x4*)(hp + 128); R.h3 = *(const f32x4*)(hp + 132); }
    __device__ __forceinline__ void fin(const f32x4 a0, const f32x4 a1, const f32x4 b0, const f32x4 b1, int row, const pg8::Unit& u, int wc, int fq, const Regs& R) const {
        const size_t o = (size_t)row * D + u.pn * 256 + wc * 32 + 8 * fq; float* hp = h + o;
        const f32x4 v0 = R.h0 + a0 * scale, v1 = R.h1 + a1 * scale, w0 = R.h2 + b0 * scale, w1 = R.h3 + b1 * scale;
        *(f32x4*)hp = v0; *(f32x4*)(hp + 4) = v1; *(f32x4*)(hp + 128) = w0; *(f32x4*)(hp + 132) = w1;
        *(u32x4*)(hb + o) = pack8(v0, v1); *(u32x4*)(hb + o + 128) = pack8(w0, w1);
        float ss = sumsq8(v0, v1) + sumsq8(w0, w1); ss += __shfl_xor(ss, 16); ss += __shfl_xor(ss, 32);
        if (fq == 0) ssq_out[(size_t)row * 32 + u.pn * 4 + wc] = ss;
    }
};
struct EpiWin {
    bf16_t *ua, *ub, *sga, *sgb; const float* ssq;
    typedef SsqRegs Regs; static constexpr int BATCH = 5; static constexpr bool HAS_LOADS = true;
    __device__ __forceinline__ void load(int row, const pg8::Unit&, int, int fq, Regs& R) const { ssq_load(ssq, row, fq, R); }
    __device__ __forceinline__ void fin(const f32x4 a0, const f32x4 a1, const f32x4 b0, const f32x4 b1, int row, const pg8::Unit& u, int wc, int fq, const Regs& R) const {
        int colt = u.pn * 256; bf16_t* base; int ld; bool sg;
        if (u.pn < 4) { base = ua; ld = SW; sg = false; } else if (u.pn < 8) { base = ub; ld = PW; sg = false; colt -= 1024; }
        else if (u.pn < 16) { base = sga; ld = D; sg = true; colt -= 2048; } else { base = sgb; ld = D; sg = true; colt -= 4096; }
        const float rs = rstd_from(R); f32x4 v0, v1, w0, w1;
        if (sg) { const float c = rs * -1.4426950408889634f; v0 = sigk4(a0 * c, 1.0f); v1 = sigk4(a1 * c, 1.0f); w0 = sigk4(b0 * c, 1.0f); w1 = sigk4(b1 * c, 1.0f); }
        else { v0 = a0 * rs; v1 = a1 * rs; w0 = b0 * rs; w1 = b1 * rs; }
        bf16_t* p = base + (size_t)row * ld + colt + wc * 32 + 8 * fq;
        *(u32x4*)p = pack8(v0, v1); *(u32x4*)(p + 128) = pack8(w0, w1);
    }
};
struct EpiGlu {
    const bf16_t* sga; bf16_t* part;
    struct Regs { u32x4 s; }; static constexpr int BATCH = 9; static constexpr bool HAS_LOADS = true;
    __device__ __forceinline__ void load(int row, const pg8::Unit& u, int wc, int fq, Regs& R) const { R.s = *(const u32x4*)(sga + (size_t)row * D + u.pn * 128 + wc * 32 + 8 * fq); }
    __device__ __forceinline__ void fin(const f32x4 a0, const f32x4 a1, const f32x4 b0, const f32x4 b1, int row, const pg8::Unit& u, int wc, int fq, const Regs& R) const {
        const size_t o = (size_t)row * D + u.pn * 128 + wc * 32 + 8 * fq;
        f32x4 s0, s1; unpack8(R.s, s0, s1);
        *(u32x4*)(part + o) = pack8((s0 * a0) * sigk4(b0 * -1.4426950408889634f, 1.0f), (s1 * a1) * sigk4(b1 * -1.4426950408889634f, 1.0f));
    }
};
struct EpiPoolUp {
    const bf16_t* sgb; const bf16_t* part; bf16_t* mrg;
    struct Regs { u32x4 s0, p0, s1, p1; }; static constexpr int BATCH = 3; static constexpr bool HAS_LOADS = true;
    __device__ __forceinline__ void load(int row, const pg8::Unit& u, int wc, int fq, Regs& R) const {
        const size_t o = (size_t)row * D + u.pn * 256 + wc * 32 + 8 * fq; R.s0 = *(const u32x4*)(sgb + o); R.p0 = *(const u32x4*)(part + o); R.s1 = *(const u32x4*)(sgb + o + 128); R.p1 = *(const u32x4*)(part + o + 128); }
    __device__ __forceinline__ void fin(const f32x4 a0, const f32x4 a1, const f32x4 b0, const f32x4 b1, int row, const pg8::Unit& u, int wc, int fq, const Regs& R) const {
        const size_t o = (size_t)row * D + u.pn * 256 + wc * 32 + 8 * fq;
        f32x4 s0, s1, p0, p1, t0, t1, q0, q1; unpack8(R.s0, s0, s1); unpack8(R.p0, p0, p1); unpack8(R.s1, t0, t1); unpack8(R.p1, q0, q1);
        *(u32x4*)(mrg + o) = pack8(p0 + s0 * a0, p1 + s1 * a1); *(u32x4*)(mrg + o + 128) = pack8(q0 + t0 * b0, q1 + t1 * b1);
    }
};
struct EpiStore {
    bf16_t* out; int ldc;
    struct Regs {}; static constexpr int BATCH = 1; static constexpr bool HAS_LOADS = false;
    __device__ __forceinline__ void load(int, const pg8::Unit&, int, int, Regs&) const {}
    __device__ __forceinline__ void fin(const f32x4 a0, const f32x4 a1, const f32x4 b0, const f32x4 b1, int row, const pg8::Unit& u, int wc, int fq, const Regs&) const {
        bf16_t* p = out + (size_t)row * ldc + u.pn * 256 + wc * 32 + 8 * fq; *(u32x4*)p = pack8(a0, a1); *(u32x4*)(p + 128) = pack8(b0, b1);
    }
};
struct EpiPle {
    float* h; const bf16_t* t1; bf16_t* hb; const float* ssq; float* ssq_out;
    struct Regs { SsqRegs q; f32x4 h0, h1, h2, h3; u32x4 ta, tb; }; static constexpr int BATCH = 2; static constexpr bool HAS_LOADS = true;
    __device__ __forceinline__ void load(int row, const pg8::Unit& u, int wc, int fq, Regs& R) const {
        ssq_load(ssq, row, fq, R.q); const size_t o = (size_t)row * D + u.pn * 256 + wc * 32 + 8 * fq; const float* hp = h + o;
        R.h0 = *(const f32x4*)hp; R.h1 = *(const f32x4*)(hp + 4); R.h2 = *(const f32x4*)(hp + 128); R.h3 = *(const f32x4*)(hp + 132); R.ta = *(const u32x4*)(t1 + o); R.tb = *(const u32x4*)(t1 + o + 128); }
    __device__ __forceinline__ void fin(const f32x4 a0, const f32x4 a1, const f32x4 b0, const f32x4 b1, int row, const pg8::Unit& u, int wc, int fq, const Regs& R) const {
        const float rs = rstd_from(R.q);
        const size_t o = (size_t)row * D + u.pn * 256 + wc * 32 + 8 * fq; float* hp = h + o;
        f32x4 t0, t1v, t2, t3; unpack8(R.ta, t0, t1v); unpack8(R.tb, t2, t3);
        f32x4 v0 = R.h0, v1 = R.h1, w0 = R.h2, w1 = R.h3;
        { const float c = rs * -1.4426950408889634f; v0 += t0 * sigk4(a0 * c, 1.0f); v1 += t1v * sigk4(a1 * c, 1.0f); w0 += t2 * sigk4(b0 * c, 1.0f); w1 += t3 * sigk4(b1 * c, 1.0f); }
        *(f32x4*)hp = v0; *(f32x4*)(hp + 4) = v1; *(f32x4*)(hp + 128) = w0; *(f32x4*)(hp + 132) = w1;
        *(u32x4*)(hb + o) = pack8(v0, v1); *(u32x4*)(hb + o + 128) = pack8(w0, w1);
        float ss = sumsq8(v0, v1) + sumsq8(w0, w1); ss += __shfl_xor(ss, 16); ss += __shfl_xor(ss, 32);
        if (fq == 0) ssq_out[(size_t)row * 32 + u.pn * 4 + wc] = ss;
    }
};
struct WeffOrder {
    int c;
    __device__ __forceinline__ bool next(int i, pg8::Unit& u) const {
        if (i != 0 || c < 0 || c >= 32) return false;
        const int gi = c >> 3; u.pm = c & 7; u.pn = gi; u.xoff = 0;
        u.aoff = (unsigned)(gi * 512 + (size_t)u.pm * 256 * PW * 2); u.boff = (unsigned)(gi * 131072); return true;
    }
};
struct GluOrder {
    pg8::StaticOrder base;
    __device__ __forceinline__ bool next(int i, pg8::Unit& u) const {
        if (!base.next(i >> 1, u)) return false;
        u.pn = 2 * u.pn + (i & 1); u.boff = (unsigned)u.pn * base.tb; return true;
    }
};
struct EpiWeff {
    bf16_t* weff;
    struct Regs {}; static constexpr int BATCH = 1; static constexpr bool HAS_LOADS = false;
    __device__ __forceinline__ void load(int, const pg8::Unit&, int, int, Regs&) const {}
    __device__ __forceinline__ void fin(const f32x4 a0, const f32x4 a1, const f32x4 b0, const f32x4 b1, int row, const pg8::Unit& u, int wc, int fq, const Regs&) const {
        bf16_t* p = weff + (size_t)row * PW + u.pn * 256 + wc * 32 + 8 * fq;
        *(u32x4*)p = pack8(a0, a1); *(u32x4*)(p + 128) = pack8(b0, b1);
    }
};

#define XB_TMO      128
#define XB_XCNT(j)  (256  + 64 * (j))
#define XB_XSUB(j)  (1280 + 64 * (j))
#define XB_XGEN(j)  (2304 + 64 * (j))
#define XB_TOP      3328
#define XB_TOPGEN   3392
#define XCD_BAR_WORDS 3456
#define XB_SPIN_CAP (1u << 22)
__device__ __forceinline__ unsigned xb_ld(unsigned* p)              { return __hip_atomic_load(p, __ATOMIC_RELAXED, __HIP_MEMORY_SCOPE_AGENT); }
__device__ __forceinline__ unsigned xb_add(unsigned* p, unsigned v) { return __hip_atomic_fetch_add(p, v, __ATOMIC_RELAXED, __HIP_MEMORY_SCOPE_AGENT); }
__device__ __forceinline__ unsigned xb_xcc_id() { return (unsigned)__builtin_amdgcn_s_getreg((3 << 11) | 20) & 0xFu; }
#define XB_SPIN(cond, bar) do { unsigned _sp = 0; while (cond) { __builtin_amdgcn_s_sleep(1); \
    if ((++_sp & 255u) == 0u) { if (xb_ld(&(bar)[XB_TMO])) break; if (_sp > XB_SPIN_CAP) { atomicAdd(&(bar)[XB_TMO], 1u); break; } } } } while (0)
struct XcdBarrier { unsigned* bar; unsigned x; volatile LAS unsigned* st; unsigned G; };
__device__ __forceinline__ XcdBarrier xcd_barrier_post(unsigned* bar, volatile LAS unsigned* st, bool t0, unsigned G) {
    XcdBarrier b; b.bar = bar; b.x = xb_xcc_id(); b.st = st; b.G = G;
    if (t0) (void)xb_add(&bar[XB_XCNT(b.x)], 1u);
    return b;
}
__device__ __forceinline__ void xcd_barrier_complete(unsigned* bar, unsigned x, unsigned& nloc, unsigned& nx, unsigned G) {
    unsigned sum, cnt, mine, sp = 0u;
    for (;;) {
        sum = 0u; cnt = 0u; mine = 0u;
#pragma unroll
        for (unsigned j = 0; j < 16; ++j) { const unsigned c = xb_ld(&bar[XB_XCNT(j)]); sum += c; cnt += (c > 0u) ? 1u : 0u; mine = (j == x) ? c : mine; }
        if (sum == G) break;
        __builtin_amdgcn_s_sleep(1);
        if ((++sp & 255u) == 0u) { if (xb_ld(&bar[XB_TMO])) break; if (sp > XB_SPIN_CAP) { atomicAdd(&bar[XB_TMO], 1u); break; } }
    }
    nloc = mine > 0u ? mine : 1u; nx = cnt > 0u ? cnt : 1u;
}
__device__ __forceinline__ void xcd_barrier_top() { asm volatile("s_waitcnt vmcnt(0)" ::: "memory"); __syncthreads(); }
__device__ __forceinline__ void xcd_barrier_rest(const XcdBarrier& b, bool t0) {
    if (t0) {
        unsigned* bar = b.bar;
        asm volatile("s_waitcnt lgkmcnt(0)" ::: "memory");
        unsigned nloc = b.st[0], nx = b.st[1];
        if (nloc == 0u) { xcd_barrier_complete(bar, b.x, nloc, nx, b.G); b.st[0] = nloc; b.st[1] = nx; }
        const unsigned old = xb_add(&bar[XB_XSUB(b.x)], 1u);
        const unsigned gen = old / nloc;
        if (nx == 1u) {
            __builtin_amdgcn_fence(__ATOMIC_ACQUIRE, "agent");
            XB_SPIN(xb_ld(&bar[XB_XSUB(b.x)]) < (gen + 1u) * nloc, bar);
            asm volatile("s_waitcnt vmcnt(0)" ::: "memory");
        } else if (old + 1u == (gen + 1u) * nloc) {
            __builtin_amdgcn_fence(__ATOMIC_RELEASE, "agent");
            asm volatile("s_waitcnt vmcnt(0)" ::: "memory");
            const unsigned og = xb_add(&bar[XB_TOP], 1u);
            const unsigned tg = og / nx;
            if (og + 1u == (tg + 1u) * nx) xb_add(&bar[XB_TOPGEN], 1u);
            else XB_SPIN(xb_ld(&bar[XB_TOPGEN]) == tg, bar);
            __builtin_amdgcn_fence(__ATOMIC_ACQUIRE, "agent");
            xb_add(&bar[XB_XGEN(b.x)], 1u);
            asm volatile("s_waitcnt vmcnt(0)" ::: "memory");
        } else {
            XB_SPIN(xb_ld(&bar[XB_XGEN(b.x)]) == gen, bar);
            __builtin_amdgcn_fence(__ATOMIC_ACQUIRE, "agent");
            asm volatile("s_waitcnt vmcnt(0)" ::: "memory");
        }
    }
    __syncthreads();
}
__device__ __forceinline__ void xcd_barrier(const XcdBarrier& b, bool t0) { xcd_barrier_top(); xcd_barrier_rest(b, t0); }
struct BarPre { const XcdBarrier& b; bool on, t0;
    __device__ __forceinline__ void top() const { if (on) xcd_barrier_top(); }
    __device__ __forceinline__ void rest() const { if (on) xcd_barrier_rest(b, t0); } };

__device__ __forceinline__ void evt_arrive(unsigned* w, bool t0) {
    asm volatile("s_waitcnt vmcnt(0)" ::: "memory"); __syncthreads();
    if (t0) { __builtin_amdgcn_fence(__ATOMIC_RELEASE, "agent"); asm volatile("s_waitcnt vmcnt(0)" ::: "memory"); (void)xb_add(w, 1u); }
}
__device__ __forceinline__ void evt_arrive_wt(unsigned* w, bool t0) {
    asm volatile("s_waitcnt vmcnt(0)" ::: "memory"); __syncthreads();
    if (t0) (void)xb_add(w, 1u);
}
__device__ __forceinline__ void evt_wait(unsigned* w, unsigned target, unsigned* tmo, bool t0) {
    if (t0) { unsigned sp = 0u;
        while (xb_ld(w) < target) { __builtin_amdgcn_s_sleep(1); if ((++sp & 255u) == 0u) { if (xb_ld(tmo)) break; if (sp > XB_SPIN_CAP) { atomicAdd(tmo, 1u); break; } } }
        __builtin_amdgcn_fence(__ATOMIC_ACQUIRE, "agent"); asm volatile("s_waitcnt vmcnt(0)" ::: "memory"); }
    __syncthreads();
}

struct Args { const float* in[N_IN]; float* out; unsigned char* ws; int ph_lo, ph_hi; };
static_assert(sizeof(Args) == (N_IN + 2) * 8 + 8, "Args has no padding");
typedef const __attribute__((address_space(4))) Args* CArgs;
__device__ __forceinline__ CArgs args_ptr() { CArgs p = (CArgs)__builtin_amdgcn_kernarg_segment_ptr(); asm volatile("" : "+s"(p)); return p; }

constexpr int CT_PITCH = 144;
struct ConvJob { const float* W; bf16_t* WT; const float* gain; int K, N, mode; };
__device__ __forceinline__ void conv_load(const ConvJob& J, int item, int lane, f32x4 (&v)[16], int& k0, int& n0) {
    const int nblk = J.N / 64, kb = item / nblk, nb = item % nblk; k0 = 64 * kb; n0 = 64 * nb;
    const float* src = J.W + (size_t)(k0 + 16 * (lane >> 4)) * J.N + n0 + 4 * (lane & 15);
#pragma unroll
    for (int i = 0; i < 16; ++i) v[i] = *(const f32x4*)(src + (size_t)i * J.N);
    if (J.gain) { const f32x4* gp = (const f32x4*)(J.gain + k0 + 16 * (lane >> 4));
#pragma unroll
        for (int i4 = 0; i4 < 4; ++i4) { const f32x4 gq = gp[i4];
#pragma unroll
            for (int e = 0; e < 4; ++e) v[4 * i4 + e] *= gq[e]; } }
}
__device__ __forceinline__ void conv_store(const ConvJob& J, int k0, int n0, int lane, const f32x4 (&v)[16], LAS unsigned char* img) {
#pragma unroll
    for (int j = 0; j < 4; ++j) { LAS unsigned char* p = img + (4 * (lane & 15) + j) * CT_PITCH + 32 * (lane >> 4);
        u32x4 lo, hi; lo.x = cvt_pk_bf16(v[0][j], v[1][j]); lo.y = cvt_pk_bf16(v[2][j], v[3][j]); lo.z = cvt_pk_bf16(v[4][j], v[5][j]); lo.w = cvt_pk_bf16(v[6][j], v[7][j]);
        hi.x = cvt_pk_bf16(v[8][j], v[9][j]); hi.y = cvt_pk_bf16(v[10][j], v[11][j]); hi.z = cvt_pk_bf16(v[12][j], v[13][j]); hi.w = cvt_pk_bf16(v[14][j], v[15][j]);
        *(LAS u32x4*)p = lo; *(LAS u32x4*)(p + 16) = hi; }
    LDS_WAIT(); asm volatile("" ::: "memory");
#pragma unroll
    for (int jj = 0; jj < 8; ++jj) { const int n = (lane >> 3) + 8 * jj, ng = n0 + n; const int r = J.mode == 0 ? ng : (256 * (ng >> 7) + (J.mode == 2 ? 128 : 0) + (ng & 127));
        const u32x4 o = *(const LAS u32x4*)(img + n * CT_PITCH + 16 * (lane & 7));
        { bf16_t* gp = J.WT + (size_t)r * J.K + k0 + 8 * (lane & 7); asm volatile("global_store_dwordx4 %0, %1, off sc1\n\ts_nop 1" :: "v"(gp), "v"(o) : "memory"); } }
    LDS_WAIT(); asm volatile("" ::: "memory");
}
constexpr int CI_FF = (D / 64) * (FF / 64), CI_DN = (FF / 64) * (D / 64), CI_IN = (D / 64) * (NIN / 64), CI_GL = (SW / 64) * (D / 64), CI_DD = (D / 64) * (D / 64), CI_PL = (PLE / 64) * (D / 64);
constexpr int CI_LAYER = 4 * CI_FF + 2 * CI_DN + CI_IN + 3 * CI_GL + 2 * CI_DD + CI_PL;

__device__ __forceinline__ ConvJob conv_job(CArgs a, unsigned char* ws, int l, int& r) {
    unsigned char* wl = ws + WS_W + (size_t)l * WL; ConvJob J;
#define CJ(cnt, idx, Kk, Nn, dst, md, gidx, gK) if (r < (cnt)) { J.W = a->in[idx] + (size_t)l * (Kk) * (Nn); J.WT = (bf16_t*)(wl + (dst)); J.gain = (gidx) >= 0 ? a->in[(gidx) >= 0 ? (gidx) : 0] + (size_t)l * (gK) : nullptr; J.K = Kk; J.N = Nn; J.mode = md; return J; } r -= (cnt);
    CJ(CI_GL, I_WPU, PW, D, WO_PU, 0, I_PSCALE, PW)
    CJ(CI_FF, I_WG1, D, FF, WO_GU1, 1, I_GF1, D)
    CJ(CI_FF, I_WU1, D, FF, WO_GU1, 2, I_GF1, D)
    CJ(CI_DN, I_WD1, FF, D, WO_D1, 0, -1, 0)
    CJ(CI_IN, I_WIN, D, NIN, WO_IN, 0, I_GMIX, D)
    CJ(CI_GL, I_GLA, SW, D, WO_GLU, 1, -1, 0)
    CJ(CI_GL, I_GLB, SW, D, WO_GLU, 2, -1, 0)
    CJ(CI_DD, I_WOUT, D, D, WO_OUT, 0, -1, 0)
    CJ(CI_FF, I_WG2, D, FF, WO_GU2, 1, I_GF2, D)
    CJ(CI_FF, I_WU2, D, FF, WO_GU2, 2, I_GF2, D)
    CJ(CI_DN, I_WD2, FF, D, WO_D2, 0, -1, 0)
    CJ(CI_DD, I_WPG, D, D, WO_PG, 0, I_GPLE, D)
#undef CJ
    J.W = a->in[I_WPLE] + (size_t)l * PLE * D; J.WT = (bf16_t*)(wl + WO_PLE); J.gain = nullptr; J.K = PLE; J.N = D; J.mode = 0; return J;
}
__device__ __forceinline__ void conv_range(CArgs a, unsigned char* ws, int l, int lo, int hi, int idx, int stride, int lane, LAS unsigned char* img) {
    for (int it = lo + idx; it < hi; it += 2 * stride) {
        const int it2 = it + stride; const bool two = it2 < hi;
        int r1 = it, r2 = two ? it2 : it; const ConvJob J1 = conv_job(a, ws, l, r1), J2 = conv_job(a, ws, l, r2);
        f32x4 v1[16], v2[16]; int k1, n1, k2, n2;
        conv_load(J1, r1, lane, v1, k1, n1); conv_load(J2, r2, lane, v2, k2, n2);
        conv_store(J1, k1, n1, lane, v1, img);
        if (two) conv_store(J2, k2, n2, lane, v2, img);
    }
}
constexpr int CI_SPLIT = CI_GL + 2 * CI_FF + CI_DN + CI_IN;
__device__ __forceinline__ void deferred_convert(int layer, int part, int c128, int wv, LAS unsigned char* lds) {
    if (layer >= DEPTH) return;
    int wave = wv; asm volatile("" : "+s"(wave)); const int lane = lane_id();
    CArgs a = args_ptr(); unsigned char* ws = a->ws;
    const int lo = part ? CI_SPLIT : 0, hi = part ? CI_LAYER : CI_SPLIT;
    const int cut = part ? lo + 9 * 128 * NWAVES : hi;
    conv_range(a, ws, layer, lo, cut, c128 * NWAVES + wave, 128 * NWAVES, lane, lds + wave * (64 * CT_PITCH));
    if (part && c128 >= 32) conv_range(a, ws, layer, cut, hi, (c128 - 32) * NWAVES + wave, 96 * NWAVES, lane, lds + wave * (64 * CT_PITCH));
}
__device__ __forceinline__ void prologue_phase(LAS unsigned char* lds, int wv) {
    int wave = wv, G = gridDim.x, bx = blockIdx.x; asm volatile("" : "+s"(wave), "+s"(G), "+s"(bx));
    int tid = TID_FROM(wave); asm volatile("" : "+v"(tid)); const int lane = tid & 63;
    const int vcu = (G % 8 == 0) ? (bx % 8) * (G / 8) + bx / 8 : bx;
    CArgs a = args_ptr(); unsigned char* ws = a->ws;
    const int gw = vcu * NWAVES + wave, NGW = G * NWAVES;
    conv_range(a, ws, 0, 0, CI_SPLIT, gw, NGW, lane, lds + wave * (64 * CT_PITCH));
    __syncthreads();
    for (int it = gw; it < DEPTH * 1024; it += NGW) {
        const int l = it >> 10, e = (it & 1023) * 256 + lane * 4;
        const f32x4 v = *(const f32x4*)(a->in[I_WPOOL] + (size_t)l * 262144 + e);
        u32x2 o; o.x = cvt_pk_bf16(v[0], v[1]); o.y = cvt_pk_bf16(v[2], v[3]);
        *(u32x2*)((bf16_t*)(ws + WS_W + (size_t)l * WL + WO_POOL) + e) = o;
    }
    for (int it = gw; it < DEPTH * M; it += NGW) {
        const int l = it / M, m = it % M;
        const float* src = m < MP ? a->in[I_PP] + ((size_t)l * MP + m) * PLE : a->in[I_PS] + ((size_t)l * MS + (m - MP)) * PLE;
        const f32x4 v = *(const f32x4*)(src + lane * 4);
        u32x2 o; o.x = cvt_pk_bf16(v[0], v[1]); o.y = cvt_pk_bf16(v[2], v[3]);
        *(u32x2*)((bf16_t*)(ws + WS_PB) + ((size_t)l * M + m) * PLE + lane * 4) = o;
    }
    for (int m = gw; m < M; m += NGW) {
        const float* src = m < MP ? a->in[I_XP] + (size_t)m * D : a->in[I_XS] + (size_t)(m - MP) * D;
        bf16_t* hb = (bf16_t*)(ws + WS_HB0) + (size_t)m * D;
        float s = 0.f;
#pragma unroll
        for (int j = 0; j < 8; ++j) { const f32x4 v = *(const f32x4*)(src + j * 256 + lane * 4);
            u32x2 o; o.x = cvt_pk_bf16(v[0], v[1]); o.y = cvt_pk_bf16(v[2], v[3]); *(u32x2*)(hb + j * 256 + lane * 4) = o;
            s += (v[0] * v[0] + v[1] * v[1]) + (v[2] * v[2] + v[3] * v[3]); }
        s += __shfl_xor(s, 32);
        if (lane < 32) ((float*)(ws + WS_SSQ))[(size_t)m * 32 + lane] = s;
    }
}

__device__ __forceinline__ float gelu_tanh(float x) {
    const float z = 1.5957691216057308f * (x + 0.044715f * x * x * x); return x * sigmoid_f(z);
}
struct SsmCtx {
    bf16x8 bfr[2][2];
    bf16x8 cfr[4];
    float lre, lim;
    float dv[4];
};
constexpr int S_PITCH = 136;
template <int MODE>
__device__ __forceinline__ void ssm_chunk(const SsmCtx& cx, const LAS unsigned char* ut, bf16_t* ya, int row0, int g, int lane, float& sre, float& sim, LAS bf16_t* simg,
                                          const float* st_in_re, const float* st_in_im, float* st_out_re, float* st_out_im) {
    const bf16x8 af = *(const LAS bf16x8*)(ut + 32 * (lane & 31) + 16 * (lane >> 5));
    u32x2 uw[2] = {};
    if (MODE != 0) {
#pragma unroll
        for (int tb = 0; tb < 2; ++tb) uw[tb] = *(const LAS u32x2*)(ut + 32 * (16 * tb + (lane & 15)) + 8 * (lane >> 4));
    }
    f32x16 xr0 = {}, xr1 = {}, xi0 = {}, xi1 = {};
    xr0 = __builtin_amdgcn_mfma_f32_32x32x16_bf16(af, cx.bfr[0][0], xr0, 0, 0, 0);
    xr1 = __builtin_amdgcn_mfma_f32_32x32x16_bf16(af, cx.bfr[0][1], xr1, 0, 0, 0);
    xi0 = __builtin_amdgcn_mfma_f32_32x32x16_bf16(af, cx.bfr[1][0], xi0, 0, 0, 0);
    xi1 = __builtin_amdgcn_mfma_f32_32x32x16_bf16(af, cx.bfr[1][1], xi1, 0, 0, 0);
    asm volatile("s_nop 15\n\ts_nop 15\n\ts_nop 15\n\ts_nop 15\n\ts_nop 15\n\ts_nop 15\n\ts_nop 15\n\ts_nop 15" : "+v"(xr0), "+v"(xr1), "+v"(xi0), "+v"(xi1));
#pragma unroll
    for (int r = 0; r < 16; ++r) {
        auto s1 = __builtin_amdgcn_permlane32_swap(__float_as_uint(xr0[r]), __float_as_uint(xr1[r]), false, false); xr0[r] = __uint_as_float(s1[0]); xr1[r] = __uint_as_float(s1[1]);
        auto s2 = __builtin_amdgcn_permlane32_swap(__float_as_uint(xi0[r]), __float_as_uint(xi1[r]), false, false); xi0[r] = __uint_as_float(s2[0]); xi1[r] = __uint_as_float(s2[1]);
    }
    float inr[4], ini[4];
    if (MODE == 2) {
#pragma unroll
        for (int q = 0; q < 4; ++q) { inr[q] = st_in_re[(size_t)q * NG * NP]; ini[q] = st_in_im[(size_t)q * NG * NP]; }
    }
#pragma unroll
    for (int t = 0; t < 32; ++t) {
        const int r = (t & 3) + 4 * (t >> 3); const bool hi = (t & 4) != 0;
        const float xr = hi ? xr1[r] : xr0[r], xi = hi ? xi1[r] : xi0[r];
        if (MODE == 2 && (t & 7) == 0) { sre = inr[t >> 3]; sim = ini[t >> 3]; }
        const float nr = __builtin_fmaf(cx.lre, sre, __builtin_fmaf(-cx.lim, sim, xr)), ni = __builtin_fmaf(cx.lre, sim, __builtin_fmaf(cx.lim, sre, xi));
        sre = nr; sim = ni;
        if (MODE != 0) *(LAS unsigned*)(simg + t * S_PITCH + 2 * lane) = cvt_pk_bf16(sre, sim);
        if (MODE == 2 && (t & 7) == 7) { st_out_re[(size_t)(t >> 3) * NG * NP] = sre; st_out_im[(size_t)(t >> 3) * NG * NP] = sim; }
    }
    if (MODE != 0) {
        LDS_WAIT(); asm volatile("" ::: "memory");
#pragma unroll
        for (int tb = 0; tb < 2; ++tb) {
            f32x4 y = {0.f, 0.f, 0.f, 0.f};
#pragma unroll
            for (int ks = 0; ks < 4; ++ks) { const bf16x8 sf = *(const LAS bf16x8*)(simg + (16 * tb + (lane & 15)) * S_PITCH + 32 * ks + 8 * (lane >> 4));
                y = __builtin_amdgcn_mfma_f32_16x16x32_bf16(cx.cfr[ks], sf, y, 0, 0, 0); }
            asm volatile("s_nop 15\n\ts_nop 15\n\ts_nop 15\n\ts_nop 15" : "+v"(y));
            const size_t o = (size_t)(row0 + 16 * tb + (lane & 15)) * SW + 16 * g + 4 * (lane >> 4);
            const float u0 = bf_lo(uw[tb].x), u1 = bf_hi(uw[tb].x), u2 = bf_lo(uw[tb].y), u3 = bf_hi(uw[tb].y);
            u32x2 ow; ow.x = cvt_pk_bf16(gelu_tanh(y[0] + cx.dv[0] * u0), gelu_tanh(y[1] + cx.dv[1] * u1)); ow.y = cvt_pk_bf16(gelu_tanh(y[2] + cx.dv[2] * u2), gelu_tanh(y[3] + cx.dv[3] * u3));
            *(u32x2*)(ya + o) = ow;
        }
        LDS_WAIT(); asm volatile("" ::: "memory");
    }
}

template <int W> __device__ __forceinline__ void pool_prompt(const bf16_t* base, bf16_t* mo, int t0) {
    unsigned z[W - 1 + 32];
#pragma unroll
    for (int i = 0; i < W - 1 + 32; ++i) { const int j = t0 - (W - 1) + i; z[i] = (i >= W - 1 || t0 > 0) ? *(const unsigned*)(base + (ptrdiff_t)j * PW) : 0u; }
    float r0 = 0.f, r1 = 0.f;
#pragma unroll
    for (int i = 0; i < W - 1; ++i) { r0 += bf_lo(z[i]); r1 += bf_hi(z[i]); }
#pragma unroll
    for (int t = 0; t < 32; ++t) {
        const float z0 = bf_lo(z[W - 1 + t]), z1 = bf_hi(z[W - 1 + t]), w0 = r0 + z0, w1 = r1 + z1;
        const float ic = (t + 1 < W) ? (t0 > 0 ? 1.0f / W : 1.0f / (t + 1)) : 1.0f / W;
        *(unsigned*)(mo + (size_t)t * PW) = cvt_pk_bf16(w0 * ic - z0, w1 * ic - z1);
        r0 = w0 - bf_lo(z[t]); r1 = w1 - bf_hi(z[t]);
    }
}
template <int W> __device__ __forceinline__ void pool_sample(const bf16_t* base, const float* prev, bf16_t* mo) {
    float h0[W - 1], h1[W - 1]; unsigned z[DS];
#pragma unroll
    for (int i = 0; i < W - 1; ++i) { const f32x2 v = *(const f32x2*)(prev + (size_t)(PBUF - (W - 1) + i) * PW); h0[i] = v.x; h1[i] = v.y; }
#pragma unroll
    for (int t = 0; t < DS; ++t) z[t] = *(const unsigned*)(base + (size_t)t * PW);
    float r0 = 0.f, r1 = 0.f;
#pragma unroll
    for (int i = 0; i < W - 1; ++i) { r0 += h0[i]; r1 += h1[i]; }
#pragma unroll
    for (int t = 0; t < DS; ++t) {
        const float z0 = bf_lo(z[t]), z1 = bf_hi(z[t]), w0 = r0 + z0, w1 = r1 + z1;
        *(unsigned*)(mo + (size_t)t * PW) = cvt_pk_bf16(w0 * (1.0f / W) - z0, w1 * (1.0f / W) - z1);
        const int jo = t - (W - 1);
        const float o0 = jo >= 0 ? bf_lo(z[jo >= 0 ? jo : 0]) : h0[jo < 0 ? t : 0], o1 = jo >= 0 ? bf_hi(z[jo >= 0 ? jo : 0]) : h1[jo < 0 ? t : 0];
        r0 = w0 - o0; r1 = w1 - o1;
    }
}
__device__ __forceinline__ void ssm_part(int layer, LAS unsigned char* lds, int wv) {
    int wave = wv, G = gridDim.x, bx = blockIdx.x; asm volatile("" : "+s"(wave), "+s"(G), "+s"(bx));
    int tid = TID_FROM(wave); asm volatile("" : "+v"(tid)); const int lane = tid & 63;
    CArgs a = args_ptr(); unsigned char* ws = a->ws;
    const bf16_t* ua = (const bf16_t*)(ws + WS_UA); const bf16_t* ub = (const bf16_t*)(ws + WS_UB);
    bf16_t* ya = (bf16_t*)(ws + WS_YA); bf16_t* mix = (bf16_t*)(ws + WS_MIX);
    LAS float* E = (LAS float*)lds;
    LAS bf16_t* simg = (LAS bf16_t*)(lds + 4096 + wave * (32 * S_PITCH * 2));
    LAS unsigned char* utile = lds + 4096 + NWAVES * (32 * S_PITCH * 2) + wave * 9216;
    static_assert(4096 + NWAVES * (32 * S_PITCH * 2) + NWAVES * 9216 <= LDSCTL_OFF, "S5 phase LDS map");
    for (int unit = 0; unit < 1; ++unit) {
        const int sq = (bx & 7) >> 1, g = ((bx >> 3) << 1) | (bx & 1);
        SsmCtx cx;
        {
            const float dt = expf(a->in[I_LDT][layer * NG + g]);
            const float are = a->in[I_ARE][((size_t)layer * NG + g) * NP + lane], aim = a->in[I_AIM][((size_t)layer * NG + g) * NP + lane];
            const float mag = expf(are * dt); float sn, cs; sincosf(aim * dt, &sn, &cs);
            cx.lre = mag * cs; cx.lim = mag * sn;
            const float den = are * are + aim * aim, nre = cx.lre - 1.0f;
            const float kre = (nre * are + cx.lim * aim) / den, kim = (cx.lim * are - nre * aim) / den;
#pragma unroll
            for (int q = 0; q < 2; ++q) {
                const int pp = 32 * q + (lane & 31); const float kr = __shfl(kre, pp), ki = __shfl(kim, pp);
                const size_t bo = (((size_t)layer * NG + g) * NP + pp) * NH + 8 * (lane >> 5);
                const f32x4 br0 = *(const f32x4*)(a->in[I_BRE] + bo), br1 = *(const f32x4*)(a->in[I_BRE] + bo + 4), bi0 = *(const f32x4*)(a->in[I_BIM] + bo), bi1 = *(const f32x4*)(a->in[I_BIM] + bo + 4);
                const u32x4 wre = pack8(br0 * kr - bi0 * ki, br1 * kr - bi1 * ki), wim = pack8(bi0 * kr + br0 * ki, bi1 * kr + br1 * ki);
                cx.bfr[0][q] = __builtin_bit_cast(bf16x8, wre); cx.bfr[1][q] = __builtin_bit_cast(bf16x8, wim);
            }
#pragma unroll
            for (int ks = 0; ks < 4; ++ks) {
                const int h = lane & 15, p0 = 16 * ks + 4 * (lane >> 4); const size_t co = (((size_t)layer * NG + g) * NH + h) * NP + p0;
                const f32x4 cr = *(const f32x4*)(a->in[I_CRE] + co), ci = *(const f32x4*)(a->in[I_CIM] + co);
                cx.cfr[ks] = __builtin_bit_cast(bf16x8, pack8((f32x4){cr[0], -ci[0], cr[1], -ci[1]}, (f32x4){cr[2], -ci[2], cr[3], -ci[3]}));
            }
#pragma unroll
            for (int i = 0; i < 4; ++i) cx.dv[i] = a->in[I_SD][((size_t)layer * NG + g) * NH + 4 * (lane >> 4) + i];
        }
        const int rowp = sq * SEQ + wave * 256, s0 = 32 * sq + 4 * wave;
        {
            bf16x8 tl[9];
#pragma unroll
            for (int c = 0; c < 9; ++c) tl[c] = *(const bf16x8*)(ua + (size_t)((c < 8 ? rowp + 32 * c : MP + s0 * DS) + (lane & 31)) * SW + 16 * g + 8 * (lane >> 5));
#pragma unroll
            for (int c = 0; c < 9; ++c) *(LAS bf16x8*)(utile + 1024 * c + 32 * (lane & 31) + 16 * (lane >> 5)) = tl[c];
            LDS_WAIT(); asm volatile("" ::: "memory");
        }
        float sre = 0.f, sim = 0.f;
        for (int c = 0; c < 8; ++c) ssm_chunk<0>(cx, utile + 1024 * c, ya, rowp + 32 * c, g, lane, sre, sim, simg, nullptr, nullptr, nullptr, nullptr);
        E[(wave * 64 + lane) * 2] = sre; E[(wave * 64 + lane) * 2 + 1] = sim;
        LDS_WAIT(); __syncthreads();
        float pr = cx.lre, pi = cx.lim;
#pragma unroll
        for (int i = 0; i < 8; ++i) { const float nr = pr * pr - pi * pi, ni = 2.f * pr * pi; pr = nr; pi = ni; }
        sre = 0.f; sim = 0.f;
        for (int v = 0; v < wave; ++v) { const float er = E[(v * 64 + lane) * 2], ei = E[(v * 64 + lane) * 2 + 1]; const float nr = pr * sre - pi * sim + er, ni = pr * sim + pi * sre + ei; sre = nr; sim = ni; }
        for (int c = 0; c < 8; ++c) ssm_chunk<1>(cx, utile + 1024 * c, ya, rowp + 32 * c, g, lane, sre, sim, simg, nullptr, nullptr, nullptr, nullptr);
        if (wave == 7) { a->out[O_SRP + (((size_t)layer * NB + sq) * NG + g) * NP + lane] = sre; a->out[O_SIP + (((size_t)layer * NB + sq) * NG + g) * NP + lane] = sim; }
        {
            const size_t so = (((size_t)layer * DB + s0) * NG + g) * NP + lane;
            float tr = 0.f, ti = 0.f;
            ssm_chunk<2>(cx, utile + 1024 * 8, ya, MP + s0 * DS, g, lane, tr, ti, simg, a->in[I_SRE] + so, a->in[I_SIM] + so, a->out + O_SRS + so, a->out + O_SIS + so);
        }
        __syncthreads();
    }
}
__device__ __forceinline__ void pool_part(int layer, int wv) {
    int wave = wv, G = gridDim.x, bx = blockIdx.x; asm volatile("" : "+s"(wave), "+s"(G), "+s"(bx));
    int tid = TID_FROM(wave); asm volatile("" : "+v"(tid)); const int lane = tid & 63;
    CArgs a = args_ptr(); unsigned char* ws = a->ws;
    const bf16_t* ua = (const bf16_t*)(ws + WS_UA); const bf16_t* ub = (const bf16_t*)(ws + WS_UB);
    bf16_t* ya = (bf16_t*)(ws + WS_YA); bf16_t* mix = (bf16_t*)(ws + WS_MIX);
    const int pair = (bx & 7) >> 1, pj = ((bx >> 3) << 1) | (bx & 1);
    const int gw = pj * NWAVES + wave, NGW = 64 * NWAVES;
    for (int it = gw; it < 64 * 8; it += NGW) {
        const int cb = it & 7, ts = (it >> 3) & 63, b = pair; const int c = cb * 128 + 2 * lane, t0 = ts * 32;
        const bf16_t* base = ub + (size_t)b * SEQ * PW + c; bf16_t* mo = mix + ((size_t)b * SEQ + t0) * PW + c;
        switch (cb >> 1) { case 0: pool_prompt<2>(base, mo, t0); break; case 1: pool_prompt<4>(base, mo, t0); break; case 2: pool_prompt<8>(base, mo, t0); break; default: pool_prompt<16>(base, mo, t0); break; }
    }
    for (int it = gw; it < 32 * 8; it += NGW) {
        const int cb = it & 7, b = 32 * pair + (it >> 3); const int c = cb * 128 + 2 * lane;
        const bf16_t* base = ub + ((size_t)MP + b * DS) * PW + c; const float* prev = a->in[I_SPOOL] + (((size_t)layer * DB + b) * PBUF) * PW + c; bf16_t* mo = mix + ((size_t)MP + b * DS) * PW + c;
        switch (cb >> 1) { case 0: pool_sample<2>(base, prev, mo); break; case 1: pool_sample<4>(base, prev, mo); break; case 2: pool_sample<8>(base, prev, mo); break; default: pool_sample<16>(base, prev, mo); break; }
    }
    const int gt = pj * NTHREADS + tid, NGT = 64 * NTHREADS;
    for (int e = gt; e < PBUF * (PW / 4); e += NGT) {
        const int c4 = e & 255, r = (e >> 8) % PBUF, b = pair;
        const u32x2 z = *(const u32x2*)(ub + ((size_t)b * SEQ + (SEQ - PBUF) + r) * PW + 4 * c4);
        *(f32x4*)(a->out + O_PP + (((size_t)layer * NB + b) * PBUF + r) * PW + 4 * c4) = (f32x4){bf_lo(z.x), bf_hi(z.x), bf_lo(z.y), bf_hi(z.y)};
    }
    for (int e = gt; e < 32 * PBUF * (PW / 4); e += NGT) {
        const int c4 = e & 255, r = (e >> 8) % PBUF, b = 32 * pair + (e >> 8) / PBUF; f32x4 v;
        if (r < PBUF - DS) v = *(const f32x4*)(a->in[I_SPOOL] + (((size_t)layer * DB + b) * PBUF + DS + r) * PW + 4 * c4);
        else { const u32x2 z = *(const u32x2*)(ub + ((size_t)MP + b * DS + (r - (PBUF - DS))) * PW + 4 * c4); v = (f32x4){bf_lo(z.x), bf_hi(z.x), bf_lo(z.y), bf_hi(z.y)}; }
        *(f32x4*)(a->out + O_PS + (((size_t)layer * DB + b) * PBUF + r) * PW + 4 * c4) = v;
    }
}

__device__ __forceinline__ void final_phase(int wv) {
    int wave = wv, G = gridDim.x, bx = blockIdx.x; asm volatile("" : "+s"(wave), "+s"(G), "+s"(bx));
    int tid = TID_FROM(wave); asm volatile("" : "+v"(tid)); const int lane = tid & 63;
    CArgs a = args_ptr(); const float* h = (const float*)(a->ws + WS_H); const float* ssq = (const float*)(a->ws + WS_SSQ);
    const int pair = (bx & 7) >> 1, pj = ((bx >> 3) << 1) | (bx & 1);
    const int gw = pj * NWAVES + wave, NGW = 64 * NWAVES;
    for (int r = gw; r < SEQ + 32 * DS; r += NGW) {
        const int m = r < SEQ ? pair * SEQ + r : MP + pair * (32 * DS) + (r - SEQ);
        const float s = wave_sum(lane < 32 ? ssq[(size_t)m * 32 + lane] : 0.f);
        const float rs = __builtin_amdgcn_rsqf(s * (1.0f / D) + RMS_EPS);
#pragma unroll
        for (int j = 0; j < 8; ++j) { const f32x4 v = *(const f32x4*)(h + (size_t)m * D + j * 256 + lane * 4), gn = *(const f32x4*)(a->in[I_GFIN] + j * 256 + lane * 4);
            *(f32x4*)(a->out + O_Y + (size_t)m * D + j * 256 + lane * 4) = v * rs * gn; }
    }
}

constexpr int PH_PER_LAYER = 10, PH_LAYER0 = 2, PH_FINAL = PH_LAYER0 + DEPTH * PH_PER_LAYER, N_PHASES = PH_FINAL + 1;

__global__ void __launch_bounds__(NTHREADS, 2) fwd(Args args) {
    extern __shared__ __attribute__((aligned(16))) unsigned char lds_raw[];
    LAS unsigned char* lds = (LAS unsigned char*)lds_raw;
    volatile LAS unsigned* MISC = (volatile LAS unsigned*)(lds + MISC_OFF);
    const int tid = threadIdx.x; const int wave0 = __builtin_amdgcn_readfirstlane(tid >> 6);
    const int G0 = gridDim.x; const int bx0 = blockIdx.x;
    for (int u = tid; u < (LDS_BYTES - LDSCTL_OFF) / 4; u += NTHREADS) ((LAS unsigned*)(lds + LDSCTL_OFF))[u] = 0u;
    __syncthreads();
    const int lo = args.ph_lo, hi = args.ph_hi;
    XcdBarrier bar; bar.bar = (unsigned*)(args.ws + WS_CTL) + CW_BAR; bar.x = 0; bar.st = nullptr; bar.G = (unsigned)G0;
    XcdBarrier gbar = bar, pbar = bar;
    if (hi - lo > 1) { bar = xcd_barrier_post((unsigned*)(args.ws + WS_CTL) + CW_BAR, MISC + 8, tid == 0, (unsigned)G0);
        gbar = xcd_barrier_post((unsigned*)(args.ws + WS_CTL) + 4096 * (1 + (bx0 & 7)), MISC + 10, tid == 0, (unsigned)(G0 / 8));
        pbar = xcd_barrier_post((unsigned*)(args.ws + WS_CTL) + 4096 * (9 + ((bx0 & 7) >> 1)), MISC + 12, tid == 0, (unsigned)(G0 / 4)); }
#define EVT(e) ((unsigned*)(args_ptr()->ws + WS_CTL) + 4096 * 13 + 64 * (e))
#define EVT_TMO ((unsigned*)(args_ptr()->ws + WS_CTL) + CW_BAR + XB_TMO)
#define IN(k) (lo <= (k) && (k) < hi)
#define SEAM(k) do { if (IN((k) + 1)) xcd_barrier(bar, TID_FROM(wave0) == 0); } while (0)
#define SEAML(k) do { if (IN((k) + 1)) xcd_barrier(gbar, TID_FROM(wave0) == 0); } while (0)
#define SEAMP(k) do { if (IN((k) + 1)) xcd_barrier(pbar, TID_FROM(wave0) == 0); } while (0)
#define WSP() unsigned char* ws = args_ptr()->ws; int G = G0, bx = bx0; asm volatile("" : "+s"(G), "+s"(bx))

    if (IN(0)) { prologue_phase(lds, wave0); SEAM(1); }
    for (int layer = 0; layer < DEPTH; ++layer) {
        const int pb = PH_LAYER0 + layer * PH_PER_LAYER;
#define LAYER_PTRS() WSP(); unsigned char* wl = ws + WS_W + (size_t)layer * WL; float* H = (float*)(ws + WS_H); \
        bf16_t* hb_cur = (bf16_t*)(ws + ((layer & 1) ? WS_HB1 : WS_HB0)); bf16_t* hb_nxt = (bf16_t*)(ws + ((layer & 1) ? WS_HB0 : WS_HB1)); \
        float* ssq0 = (float*)(ws + WS_SSQ); float* ssq1 = ssq0 + (size_t)M * 32; bf16_t* act = (bf16_t*)(ws + WS_ACT); \
        (void)wl; (void)H; (void)hb_cur; (void)hb_nxt; (void)ssq0; (void)ssq1; (void)act
        if (IN(pb + 0)) { if (layer > 0 && hi - lo > 1) evt_wait(EVT(2 * layer), 128u, EVT_TMO, TID_FROM(wave0) == 0);
            LAYER_PTRS();
            pg8::Gemm g{hb_cur, (const bf16_t*)(wl + WO_GU1), D, D, D, ws}; pg8::StaticOrder S; S.init(MP, 2 * FF, D, D, G, bx);
            EpiGateUp E{act, ssq0}; pg8::gemm_phase<EpiGateUp, pg8::StaticOrder, true, BarPre>(lds, g, S, E, wave0, BarPre{gbar, layer > 0 && IN(pb - 1), TID_FROM(wave0) == 0});
            if (bx >= 128) { deferred_convert(layer, 1, bx - 128, wave0, lds); __syncthreads(); if (hi - lo > 1) evt_arrive_wt(EVT(2 * layer + 1), TID_FROM(wave0) == 0); }
            if (bx >= 128 && bx < 160) {
                pg8::Gemm g2{(const bf16_t*)(wl + WO_PU), (const bf16_t*)(wl + WO_POOL), PW, 256, 256, ws}; WeffOrder S2{bx - 128}; EpiWeff E2{(bf16_t*)(wl + WO_EFF)};
                pg8::gemm_phase<EpiWeff, WeffOrder, false>(lds, g2, S2, E2, wave0);
                if (hi - lo > 1) evt_arrive(EVT(8 + layer), TID_FROM(wave0) == 0);
            }
        }
        if (IN(pb + 1)) { LAYER_PTRS();
            pg8::Gemm g{act, (const bf16_t*)(wl + WO_D1), FF, FF, FF, ws}; pg8::StaticOrder S; S.init(MP, D, FF, FF, G, bx);
            EpiResid E{H, hb_cur, ssq1, 0.5f, layer == 0 ? args_ptr()->in[I_XP] : H, layer == 0 ? args_ptr()->in[I_XS] : H + (size_t)MP * D};
            pg8::gemm_phase<EpiResid, pg8::StaticOrder, true, BarPre>(lds, g, S, E, wave0, BarPre{gbar, IN(pb + 0), TID_FROM(wave0) == 0});
        }
        if (IN(pb + 2)) { LAYER_PTRS();
            pg8::Gemm g{hb_cur, (const bf16_t*)(wl + WO_IN), D, D, D, ws}; pg8::StaticOrder S; S.init(MP, NIN, D, D, G, bx);
            EpiWin E{(bf16_t*)(ws + WS_UA), (bf16_t*)(ws + WS_UB), (bf16_t*)(ws + WS_SGA), (bf16_t*)(ws + WS_SGB), ssq1};
            pg8::gemm_phase<EpiWin, pg8::StaticOrder, true, BarPre>(lds, g, S, E, wave0, BarPre{gbar, IN(pb + 1), TID_FROM(wave0) == 0}); SEAMP(pb + 2);
        }
        if (IN(pb + 3)) { ssm_part(layer, lds, wave0); pool_part(layer, wave0); SEAMP(pb + 3); }
        if (IN(pb + 4) && hi - lo > 1) { evt_wait(EVT(2 * layer + 1), 128u, EVT_TMO, TID_FROM(wave0) == 0); evt_wait(EVT(8 + layer), 32u, EVT_TMO, TID_FROM(wave0) == 0); }
        if (IN(pb + 4)) {
            { LAYER_PTRS(); pg8::Gemm g{(const bf16_t*)(ws + WS_YA), (const bf16_t*)(wl + WO_GLU), SW, SW, SW, ws}; GluOrder S; S.base.init(MP, D, SW, SW, G, bx);
              EpiGlu E{(const bf16_t*)(ws + WS_SGA), (bf16_t*)(ws + WS_PART)}; pg8::gemm_phase<EpiGlu, GluOrder, true>(lds, g, S, E, wave0); }
            { LAYER_PTRS(); pg8::Gemm g{(const bf16_t*)(ws + WS_MIX), (const bf16_t*)(wl + WO_EFF), PW, PW, PW, ws}; pg8::StaticOrder S; S.init(MP, D, PW, PW, G, bx);
              EpiPoolUp E{(const bf16_t*)(ws + WS_SGB), (const bf16_t*)(ws + WS_PART), (bf16_t*)(ws + WS_MRG)}; pg8::gemm_phase<EpiPoolUp, pg8::StaticOrder, true>(lds, g, S, E, wave0); }
        }
        if (IN(pb + 6)) { LAYER_PTRS();
            pg8::Gemm g{(const bf16_t*)(ws + WS_MRG), (const bf16_t*)(wl + WO_OUT), D, D, D, ws}; pg8::StaticOrder S; S.init(MP, D, D, D, G, bx);
            EpiResid E{H, hb_cur, ssq0, 1.0f, H, H + (size_t)MP * D}; pg8::gemm_phase<EpiResid, pg8::StaticOrder, true, BarPre>(lds, g, S, E, wave0, BarPre{gbar, IN(pb + 4), TID_FROM(wave0) == 0});
        }
        if (IN(pb + 7)) { LAYER_PTRS();
            pg8::Gemm g{hb_cur, (const bf16_t*)(wl + WO_GU2), D, D, D, ws}; pg8::StaticOrder S; S.init(MP, 2 * FF, D, D, G, bx);
            EpiGateUp E{act, ssq0}; pg8::gemm_phase<EpiGateUp, pg8::StaticOrder, true, BarPre>(lds, g, S, E, wave0, BarPre{gbar, IN(pb + 6), TID_FROM(wave0) == 0});
            if (bx >= 128) { deferred_convert(layer + 1, 0, bx - 128, wave0, lds); if (layer + 1 < DEPTH && hi - lo > 1) evt_arrive_wt(EVT(2 * (layer + 1)), TID_FROM(wave0) == 0); }
        }
        if (IN(pb + 8)) { LAYER_PTRS();
            pg8::Gemm g{act, (const bf16_t*)(wl + WO_D2), FF, FF, FF, ws}; pg8::StaticOrder S; S.init(MP, D, FF, FF, G, bx);
            EpiResid E{H, hb_cur, ssq1, 0.5f, H, H + (size_t)MP * D}; pg8::gemm_phase<EpiResid, pg8::StaticOrder, true, BarPre>(lds, g, S, E, wave0, BarPre{gbar, IN(pb + 7), TID_FROM(wave0) == 0});
        }
        if (IN(pb + 9)) {
            { LAYER_PTRS(); pg8::Gemm g{(const bf16_t*)(ws + WS_PB) + (size_t)layer * M * PLE, (const bf16_t*)(wl + WO_PLE), PLE, PLE, PLE, ws}; pg8::StaticOrder S; S.init(MP, D, PLE, PLE, G, bx);
              EpiStore E{(bf16_t*)(ws + WS_T1), D}; pg8::gemm_phase<EpiStore, pg8::StaticOrder, true, BarPre>(lds, g, S, E, wave0, BarPre{gbar, IN(pb + 8), TID_FROM(wave0) == 0}); }
            { LAYER_PTRS(); pg8::Gemm g{hb_cur, (const bf16_t*)(wl + WO_PG), D, D, D, ws}; pg8::StaticOrder S; S.init(MP, D, D, D, G, bx);
              EpiPle E{H, (const bf16_t*)(ws + WS_T1), hb_nxt, ssq1, ssq0}; pg8::gemm_phase<EpiPle, pg8::StaticOrder, true>(lds, g, S, E, wave0); }
            if (layer + 1 == DEPTH) SEAMP(pb + 9);
        }
    }
    if (IN(PH_FINAL)) final_phase(wave0);
#undef IN
#undef SEAM
#undef SEAML
#undef SEAMP
}

extern "C" void kernel_launch(void* const* d_in, const int* in_sizes, int n_in, void* d_out, int out_size, void* d_ws, size_t ws_size, hipStream_t stream) {
    static int grid = 0;
    if (grid == 0) {
        if (n_in != N_IN || (size_t)out_size != O_END || ws_size < WS_END) { fprintf(stderr, "kernel_launch: unexpected shapes: n_in %d out %d ws %zu (need %zu)\n", n_in, out_size, ws_size, (size_t)WS_END); grid = -1; return; }
        int dev = 0, cus = 0, per_cu = 0;
        if (hipGetDevice(&dev) != hipSuccess || hipDeviceGetAttribute(&cus, hipDeviceAttributeMultiprocessorCount, dev) != hipSuccess) { grid = -1; return; }
        if (hipFuncSetAttribute((const void*)fwd, hipFuncAttributeMaxDynamicSharedMemorySize, LDS_BYTES) != hipSuccess) { fprintf(stderr, "kernel_launch: hipFuncSetAttribute failed\n"); grid = -1; return; }
        if (hipOccupancyMaxActiveBlocksPerMultiprocessor(&per_cu, (const void*)fwd, NTHREADS, LDS_BYTES) != hipSuccess || per_cu < 1) fprintf(stderr, "kernel_launch: occupancy query reports %d\n", per_cu);
        (void)hipGetLastError();
        if (cus < 256) { fprintf(stderr, "kernel_launch: built for a 256-CU device (one resident workgroup per CU), found %d CUs; nothing launched\n", cus); grid = -1; return; }
        grid = 256;
    }
    if (grid < 0) return;
    (void)hipMemsetAsync((char*)d_ws + WS_CTL, 0, CTL_ZERO_BYTES, stream);
    Args a{};
    for (int i = 0; i < N_IN; ++i) a.in[i] = (const float*)d_in[i];
    a.out = (float*)d_out; a.ws = (unsigned char*)d_ws;
#if MK_ONE_LAUNCH
    a.ph_lo = 0; a.ph_hi = N_PHASES;
    hipLaunchKernelGGL(fwd, dim3(grid), dim3(NTHREADS), LDS_BYTES, stream, a);
#else
    for (int p = 0; p < N_PHASES; ++p) { a.ph_lo = p; a.ph_hi = p + 1; hipLaunchKernelGGL(fwd, dim3(grid), dim3(NTHREADS), LDS_BYTES, stream, a); }
#endif
    const hipError_t le = hipPeekAtLastError();
    if (le != hipSuccess) fprintf(stderr, "kernel_launch: launch failed: %s\n", hipGetErrorName(le));
}
```

```cpp
#include <hip/hip_runtime.h>
#include <cstdio>

#ifndef MK_ONE_LAUNCH
#define MK_ONE_LAUNCH 1
#endif

#define GAS __attribute__((address_space(1)))
#define LAS __attribute__((address_space(3)))
typedef unsigned short bf16_t;
typedef short bf16x8 __attribute__((ext_vector_type(8)));
typedef float f32x4 __attribute__((ext_vector_type(4)));
typedef float f32x2 __attribute__((ext_vector_type(2)));
typedef float f32x16 __attribute__((ext_vector_type(16)));
typedef unsigned u32x4 __attribute__((ext_vector_type(4)));
typedef unsigned u32x2 __attribute__((ext_vector_type(2)));
typedef GAS unsigned gu32;
#define RLX_AGENT __ATOMIC_RELAXED, __HIP_MEMORY_SCOPE_AGENT
#define LDS_WAIT() asm volatile("s_waitcnt lgkmcnt(0)" ::: "memory")
#define VM_WAIT() asm volatile("s_waitcnt vmcnt(0)" ::: "memory")

constexpr int D = 2048, FF = 5632, NIN = 6144, DEPTH = 4;
constexpr int SEQ = 2048, NB = 4, DB = 128, DS = 8;
constexpr int MP = NB * SEQ, MS = DB * DS, M = MP + MS;
constexpr int SW = 1024, PW = 1024, NG = 64, NP = 64, NH = 16, PLE = 256, PBUF = 15;
constexpr float RMS_EPS = 1e-6f;
constexpr int NWAVES = 8, NTHREADS = 512;

enum { I_XP = 0, I_XS, I_SRE, I_SIM, I_SPOOL, I_PP, I_PS, I_GF1, I_WG1, I_WU1, I_WD1, I_GMIX, I_WIN, I_ARE, I_AIM, I_LDT, I_BRE, I_BIM, I_CRE, I_CIM, I_SD,
       I_GLA, I_GLB, I_WPOOL, I_PSCALE, I_WPU, I_WOUT, I_GF2, I_WG2, I_WU2, I_WD2, I_GPLE, I_WPLE, I_WPG, I_GFIN, N_IN };
constexpr size_t O_Y = 0, O_SRP = (size_t)M * D, O_SIP = O_SRP + 65536, O_PP = O_SIP + 65536, O_SRS = O_PP + 245760, O_SIS = O_SRS + 2097152, O_PS = O_SIS + 2097152,
                 O_END = O_PS + 7864320;

constexpr size_t MiB = 1u << 20;
constexpr size_t WS_CTL = 0, CTL_ZERO_BYTES = 14 * 16384;
constexpr size_t WO_GU1 = 0, WO_D1 = WO_GU1 + (size_t)2 * FF * D * 2, WO_IN = WO_D1 + (size_t)D * FF * 2, WO_GLU = WO_IN + (size_t)NIN * D * 2,
                 WO_PU = WO_GLU + (size_t)2 * D * SW * 2, WO_EFF = WO_PU + (size_t)D * PW * 2, WO_OUT = WO_EFF + (size_t)D * PW * 2, WO_GU2 = WO_OUT + (size_t)D * D * 2,
                 WO_D2 = WO_GU2 + (size_t)2 * FF * D * 2, WO_PG = WO_D2 + (size_t)D * FF * 2, WO_PLE = WO_PG + (size_t)D * D * 2, WO_POOL = WO_PLE + (size_t)D * PLE * 2,
                 WL = WO_POOL + (size_t)4 * 256 * 256 * 2;
constexpr size_t WS_W = 1 * MiB;
constexpr size_t WS_H = WS_W + DEPTH * WL;
constexpr size_t WS_HB0 = WS_H + (size_t)M * D * 4, WS_HB1 = WS_HB0 + (size_t)M * D * 2;
constexpr size_t WS_ACT = WS_HB1 + (size_t)M * D * 2;
constexpr size_t WS_UA = WS_ACT + (size_t)M * FF * 2, WS_UB = WS_UA + (size_t)M * SW * 2;
constexpr size_t WS_SGA = WS_UB + (size_t)M * PW * 2, WS_SGB = WS_SGA + (size_t)M * D * 2;
constexpr size_t WS_YA = WS_SGB + (size_t)M * D * 2, WS_MIX = WS_YA + (size_t)M * SW * 2;
constexpr size_t WS_PART = WS_MIX + (size_t)M * PW * 2, WS_MRG = WS_PART + (size_t)M * D * 2, WS_T1 = WS_MRG + (size_t)M * D * 2;
constexpr size_t WS_PB = WS_T1 + (size_t)M * D * 2;
constexpr size_t WS_SSQ = WS_PB + (size_t)DEPTH * M * PLE * 2;
constexpr size_t WS_END = WS_SSQ + (size_t)2 * M * 32 * 4;
static_assert(WL % 256 == 0 && WS_H % 256 == 0 && WS_SSQ % 256 == 0, "alignment");
constexpr int CW_BAR = 0;

constexpr int RING_BYTES = 131072, XS_OFF = RING_BYTES, XS_BYTES = 16384;
constexpr int LDSCTL_OFF = XS_OFF + XS_BYTES, MISC_OFF = LDSCTL_OFF + 320, LDS_BYTES = LDSCTL_OFF + 1024;

__device__ __forceinline__ int lane_id() { return (int)__builtin_amdgcn_mbcnt_hi(~0u, __builtin_amdgcn_mbcnt_lo(~0u, 0u)); }
#define TID_FROM(wv) ((wv) * 64 + lane_id())
typedef __bf16 bf16x2_t __attribute__((ext_vector_type(2)));
__device__ __forceinline__ unsigned cvt_pk_bf16(float lo, float hi) { const f32x2 v = {lo, hi}; return __builtin_bit_cast(unsigned, __builtin_convertvector(v, bf16x2_t)); }
__device__ __forceinline__ float bf_lo(unsigned w) { return __uint_as_float(w << 16); }
__device__ __forceinline__ float bf_hi(unsigned w) { return __uint_as_float(w & 0xffff0000u); }
__device__ __forceinline__ float sigmoid_f(float x) { return __builtin_amdgcn_rcpf(1.0f + __expf(-x)); }
__device__ __forceinline__ float wave_sum(float v) {
#pragma unroll
    for (int o = 1; o < 64; o <<= 1) v += __shfl_xor(v, o);
    return v;
}
struct SsqRegs { f32x4 a, b; };
__device__ __forceinline__ void ssq_load(const float* ssq, int row, int fq, SsqRegs& R) { const f32x4* p = (const f32x4*)(ssq + (size_t)row * 32 + 8 * fq); R.a = p[0]; R.b = p[1]; }
__device__ __forceinline__ float msq_from(const SsqRegs& R) {
    float s = ((R.a.x + R.a.y) + (R.a.z + R.a.w)) + ((R.b.x + R.b.y) + (R.b.z + R.b.w));
    s += __shfl_xor(s, 16); s += __shfl_xor(s, 32);
    return s * (1.0f / D) + RMS_EPS;
}
__device__ __forceinline__ f32x4 sigk4(const f32x4 t, const float kinv) {
    f32x4 e;
#pragma unroll
    for (int j = 0; j < 4; ++j) e[j] = __builtin_amdgcn_exp2f(t[j]);
    e = e * kinv + kinv;
#pragma unroll
    for (int j = 0; j < 4; ++j) e[j] = __builtin_amdgcn_rcpf(e[j]);
    return e;
}
__device__ __forceinline__ float rstd_from(const SsqRegs& R) {
    float s = ((R.a.x + R.a.y) + (R.a.z + R.a.w)) + ((R.b.x + R.b.y) + (R.b.z + R.b.w));
    s += __shfl_xor(s, 16); s += __shfl_xor(s, 32);
    return __builtin_amdgcn_rsqf(s * (1.0f / D) + RMS_EPS);
}

namespace pg8 {
constexpr int BM = 256, BK = 64, HALF = 128, HTB = HALF * BK * 2, STAGE_BYTES = 8 * HTB, NXCD = 8, WGM = 4;
__host__ __device__ __forceinline__ int lds_byte(int r, int c) { const int st = (r >> 4) * 2 + (c >> 5), rr = r & 15, cc = c & 31, ob = rr * 64 + cc * 2; return st * 1024 + (ob ^ (((ob >> 9) & 1) << 5)); }
__host__ __device__ __forceinline__ void stage_rc(int b, int& R, int& C) { const int st = b / 1024, sb = b % 1024, swz = sb ^ (((sb >> 9) & 1) << 5); R = (st >> 1) * 16 + swz / 64; C = (st & 1) * 32 + (swz % 64) / 2; }
__host__ __device__ __forceinline__ int perm32(int rho) { const int n = rho >> 4, i = rho & 15; return 8 * (i >> 2) + 4 * n + (i & 3); }

struct Unit { int pm, pn; unsigned aoff, boff, xoff; };
struct Gemm { const bf16_t* A; const bf16_t* Bt; int lda, ldb, K; const unsigned char* ws; };

struct StaticOrder {
    int nM, nN, nwg, G, c; unsigned ta, tb, tx, x0;
    __device__ void init(int Mrows, int N, int lda, int ldb, int G_, int c_) { nM = Mrows / BM; nN = N / BM; nwg = nM * nN; G = G_; c = c_; ta = (unsigned)BM * lda * 2u; tb = (unsigned)BM * ldb * 2u; tx = 32u * lda * 2u; x0 = (unsigned)MP * lda * 2u; }
    __device__ __forceinline__ bool next(int i, Unit& u) const {
        const long L = (long)i * G + c; if (L >= nwg) return false;
        int wgid = (int)L; { const int q = nwg / NXCD, r = nwg % NXCD, xcd = wgid % NXCD, off = wgid / NXCD; wgid = (xcd < r ? xcd * (q + 1) : r * (q + 1) + (xcd - r) * q) + off; }
        const int nig = WGM * nN, gid = wgid / nig, fm = gid * WGM, gsz = (nM - fm) < WGM ? (nM - fm) : WGM;
        u.pm = fm + ((wgid % nig) % gsz); u.pn = (wgid % nig) / gsz;
        u.aoff = (unsigned)u.pm * ta; u.boff = (unsigned)u.pn * tb; u.xoff = x0 + (unsigned)u.pm * tx; return true;
    }
};

struct NoExtra { __device__ __forceinline__ void after_unit(int, int, int) const {} };
struct NoPre { __device__ __forceinline__ void top() const {} __device__ __forceinline__ void rest() const {} };
template <class Epi, class Sched, bool XT, class Pre = NoPre, class Extra = NoExtra, bool ALIGN_EPI = true>
__device__ __forceinline__ void gemm_phase(LAS unsigned char* lds, const Gemm g, const Sched& S, const Epi& E, int wv, const Pre& P = Pre(), const Extra& X = Extra()) {
    asm volatile("" : "+s"(wv));
    int tid = TID_FROM(wv); asm volatile("" : "+v"(tid));
    const int wid = wv, lane = tid & 63, wr = wid >> 2, wc = wid & 3, fr = lane & 15, fq = lane >> 4;
    int K = g.K; asm volatile("" : "+s"(K));
    const int nt = K / BK;
    unsigned voffA, voffB;
    { int R, C; stage_rc(tid * 16, R, C); const int Rb = (R & ~31) + perm32(R & 31); voffA = (unsigned)(R * g.lda + C) * 2u; voffB = (unsigned)(Rb * g.ldb + C) * 2u; }
    const unsigned q_voffA = 64u * g.lda * 2u, q_voffB = 64u * g.ldb * 2u;
    const __amdgpu_buffer_rsrc_t rs = __builtin_amdgcn_make_buffer_rsrc((void*)g.ws, 0, (int)WS_END, 0x00020000);
    const unsigned oA = (unsigned)((const unsigned char*)g.A - g.ws), oB = (unsigned)((const unsigned char*)g.Bt - g.ws);
    const unsigned kstep = (unsigned)(BK * 2);
    const unsigned hstepA = (unsigned)HALF * g.lda * 2u, hstepB = (unsigned)HALF * g.ldb * 2u;
    const unsigned ldsw = (unsigned)wid * 1024u;
    const int aoff = lds_byte(wr * 64 + fr, fq * 8), boff = lds_byte(wc * 32 + fr, fq * 8);
    const int xadj = wr * (128 - 64 * g.lda); const unsigned xdst = XS_OFF + 8192u * ((wid >> 1) & 1) + 2048u * (wid >> 2) + 1024u * (wid & 1);
#define PG8_SA(b, h) (((b) * 2 + (h)) * HTB)
#define PG8_SB(b, h) ((4 + (b) * 2 + (h)) * HTB)
#define PG8_STAGE2(bufoff, gbase, voff, q) do { \
        __builtin_amdgcn_raw_ptr_buffer_load_lds(rs, (LAS unsigned*)(lds + (bufoff) + ldsw), 16, (int)(voff), (int)(gbase), 0, 0); \
        __builtin_amdgcn_raw_ptr_buffer_load_lds(rs, (LAS unsigned*)(lds + (bufoff) + ldsw + 8192), 16, (int)(voff), (int)((gbase) + (q)), 0, 0); } while (0)
#define PG8_STAGE(bufoff, gbase, voff) PG8_STAGE2(bufoff, gbase, voff, q_##voff)
#define PG8_STAGEX(slot, gbase) do { if constexpr (XT) __builtin_amdgcn_raw_ptr_buffer_load_lds(rs, (LAS unsigned*)(lds + xdst + (slot) * 4096), 16, (int)voffA, (int)(gbase) + xadj, 0, 0); } while (0)
#define PG8_LDA(dst, b, h) do { _Pragma("unroll") for (int m = 0; m < 4; ++m) _Pragma("unroll") for (int k = 0; k < 2; ++k) dst[m][k] = *(const LAS bf16x8*)(lds + PG8_SA(b, h) + aoff + m * 2048 + k * 1024); } while (0)
#define PG8_LDB(dst, b, h) do { _Pragma("unroll") for (int n = 0; n < 2; ++n) _Pragma("unroll") for (int k = 0; k < 2; ++k) dst[n][k] = *(const LAS bf16x8*)(lds + PG8_SB(b, h) + boff + n * 2048 + k * 1024); } while (0)
#define PG8_LDX(slot, kh) do { if constexpr (XT) { _Pragma("unroll") for (int k = 0; k < 2; ++k) Xf[k] = *(const LAS bf16x8*)(lds + XS_OFF + aoff + (slot) * 4096 + (kh) * 2048 + k * 1024); } } while (0)
#define PG8_MMA(ai, bj, At, Bt) do { _Pragma("unroll") for (int m = 0; m < 4; ++m) _Pragma("unroll") for (int n = 0; n < 2; ++n) _Pragma("unroll") for (int k = 0; k < 2; ++k) \
        acc[ai][bj][m][n] = __builtin_amdgcn_mfma_f32_16x16x32_bf16(Bt[n][k], At[m][k], acc[ai][bj][m][n], 0, 0, 0); } while (0)
#define PG8_MMAX() do { if constexpr (XT) { _Pragma("unroll") for (int n = 0; n < 2; ++n) _Pragma("unroll") for (int k = 0; k < 2; ++k) { \
        accx[0][n] = __builtin_amdgcn_mfma_f32_16x16x32_bf16(B0[n][k], Xf[k], accx[0][n], 0, 0, 0); accx[1][n] = __builtin_amdgcn_mfma_f32_16x16x32_bf16(B1[n][k], Xf[k], accx[1][n], 0, 0, 0); } } } while (0)
#define PG8_WAIT_V(n) asm volatile("s_waitcnt vmcnt(" #n ")" ::: "memory")
#define PG8_WAIT_VX(nx, n) do { if constexpr (XT) PG8_WAIT_V(nx); else PG8_WAIT_V(n); } while (0)
#define PG8_WAIT_L(n) asm volatile("s_waitcnt lgkmcnt(" #n ")" ::: "memory")
#define PG8_BAR __builtin_amdgcn_s_barrier()
#define PG8_SCHED __builtin_amdgcn_sched_barrier(0)
#define PG8_PRIO(p) __builtin_amdgcn_s_setprio(p)
    Unit cur, nxt; int ui = 0;
    if (!S.next(0, cur)) { P.top(); P.rest(); return; }
    f32x4 acc[2][2][4][2], accx[2][2];
#pragma unroll
    for (int a = 0; a < 2; ++a)
#pragma unroll
        for (int b = 0; b < 2; ++b) {
#pragma unroll
            for (int m = 0; m < 4; ++m)
#pragma unroll
                for (int n = 0; n < 2; ++n) acc[a][b][m][n] = (f32x4){0.f, 0.f, 0.f, 0.f};
            accx[a][b] = (f32x4){0.f, 0.f, 0.f, 0.f}; }
    bf16x8 At[4][2], B0[2][2], B1[2][2], Xf[2];
    unsigned cA = oA + cur.aoff, cB = oB + cur.boff, cX = oA + cur.xoff;
    int xs = 0;
    P.top();
    PG8_STAGE(PG8_SB(0, 0), cB, voffB); PG8_STAGE(PG8_SB(0, 1), cB + hstepB, voffB);
    P.rest();
    PG8_STAGEX(0, cX);
    PG8_STAGE(PG8_SA(0, 0), cA, voffA); PG8_STAGE(PG8_SA(0, 1), cA + hstepA, voffA);
    if (wr == 1) PG8_BAR;
    PG8_WAIT_V(2); PG8_BAR;
    PG8_STAGE(PG8_SB(1, 0), cB + kstep, voffB); PG8_STAGE(PG8_SA(1, 0), cA + kstep, voffA); PG8_STAGE(PG8_SB(1, 1), cB + hstepB + kstep, voffB);
    PG8_WAIT_V(6); PG8_BAR;
    for (;;) {
        const bool has_next = S.next(ui + 1, nxt);
        const unsigned nA = has_next ? oA + nxt.aoff : cA, nB = has_next ? oB + nxt.boff : cB, nX = has_next ? oA + nxt.xoff : cX;
        for (int t = 0; t < nt; t += 2) {
            const bool last = (t == nt - 2);
            const unsigned a1 = cA + (unsigned)(t + 1) * kstep;
            const unsigned a2 = last ? nA : cA + (unsigned)(t + 2) * kstep, b2 = last ? nB : cB + (unsigned)(t + 2) * kstep, x2 = last ? nX : cX + (unsigned)(t + 2) * kstep;
            const unsigned a3 = a2 + kstep, b3 = b2 + kstep;
            PG8_LDB(B0, 0, 0); PG8_LDB(B1, 0, 1); PG8_SCHED; PG8_LDA(At, 0, 0); PG8_LDX(xs, 0); PG8_STAGEX(xs ^ 1, x2); PG8_STAGE(PG8_SA(1, 1), a1 + hstepA, voffA);
            PG8_WAIT_VX(9, 8); PG8_WAIT_L(0); PG8_BAR; PG8_PRIO(1); PG8_MMA(0, 0, At, B0); PG8_MMA(0, 1, At, B1); PG8_MMAX(); PG8_PRIO(0); PG8_BAR; PG8_SCHED;
            PG8_LDA(At, 0, 1); PG8_STAGE(PG8_SB(0, 0), b2, voffB); PG8_STAGE(PG8_SB(0, 1), b2 + hstepB, voffB); PG8_STAGE(PG8_SA(0, 0), a2, voffA);
            PG8_WAIT_VX(9, 8); PG8_WAIT_L(0); PG8_BAR; PG8_PRIO(1); PG8_MMA(1, 0, At, B0); PG8_MMA(1, 1, At, B1); PG8_PRIO(0); PG8_BAR; PG8_SCHED;
            PG8_LDB(B0, 1, 0); PG8_LDB(B1, 1, 1); PG8_SCHED; PG8_LDA(At, 1, 0); PG8_LDX(xs, 1); PG8_STAGE(PG8_SA(0, 1), a2 + hstepA, voffA);
            PG8_WAIT_V(8); PG8_WAIT_L(0); PG8_BAR; PG8_PRIO(1); PG8_MMA(0, 0, At, B0); PG8_MMA(0, 1, At, B1); PG8_MMAX(); PG8_PRIO(0); PG8_BAR; PG8_SCHED;
            PG8_LDA(At, 1, 1); PG8_STAGE(PG8_SB(1, 0), b3, voffB); PG8_STAGE(PG8_SB(1, 1), b3 + hstepB, voffB); PG8_STAGE(PG8_SA(1, 0), a3, voffA);
            PG8_WAIT_V(8); PG8_WAIT_L(0); PG8_BAR; PG8_PRIO(1); PG8_MMA(1, 0, At, B0); PG8_MMA(1, 1, At, B1); PG8_PRIO(0); PG8_BAR; PG8_SCHED;
            xs ^= 1;
        }
        if constexpr (ALIGN_EPI) { if (wr == 0) PG8_BAR; }
        {
            asm volatile("s_nop 15\n\ts_nop 15\n\ts_nop 15\n\ts_nop 15" ::: "memory");
            int lz = lane_id(); asm volatile("" : "+v"(lz)); const int fr2 = lz & 15, fq2 = lz >> 4;
            constexpr int NR = XT ? 9 : 8, BT = Epi::BATCH;
#pragma unroll
            for (int r0 = 0; r0 < NR; r0 += BT) {
                typename Epi::Regs R[BT];
#pragma unroll
                for (int b = 0; b < BT; ++b) if (r0 + b < NR) { const int r = r0 + b; E.load(r < 8 ? cur.pm * BM + (r >> 2) * HALF + wr * 64 + (r & 3) * 16 + fr2 : MP + 32 * cur.pm + wr * 16 + fr2, cur, wc, fq2, R[b]); }
                if (Epi::HAS_LOADS) asm volatile("s_waitcnt vmcnt(0)" ::: "memory");
#pragma unroll
                for (int b = 0; b < BT; ++b) if (r0 + b < NR) { const int r = r0 + b; const int row = r < 8 ? cur.pm * BM + (r >> 2) * HALF + wr * 64 + (r & 3) * 16 + fr2 : MP + 32 * cur.pm + wr * 16 + fr2;
                    if (r < 8) E.fin(acc[r >> 2][0][r & 3][0], acc[r >> 2][0][r & 3][1], acc[r >> 2][1][r & 3][0], acc[r >> 2][1][r & 3][1], row, cur, wc, fq2, R[b]);
                    else E.fin(accx[0][0], accx[0][1], accx[1][0], accx[1][1], row, cur, wc, fq2, R[b]); }
            }
        }
        X.after_unit(ui, wid, lane_id());
        if (!has_next) break;
#pragma unroll
        for (int a = 0; a < 2; ++a)
#pragma unroll
            for (int b = 0; b < 2; ++b) {
#pragma unroll
                for (int m = 0; m < 4; ++m)
#pragma unroll
                    for (int n = 0; n < 2; ++n) acc[a][b][m][n] = (f32x4){0.f, 0.f, 0.f, 0.f};
                accx[a][b] = (f32x4){0.f, 0.f, 0.f, 0.f}; }
        cur = nxt; cA = nA; cB = nB; cX = nX; ++ui;
        if constexpr (ALIGN_EPI) { if (wr == 1) PG8_BAR; }
    }
    PG8_WAIT_V(0);
    if constexpr (!ALIGN_EPI) { if (wr == 0) PG8_BAR; }
    PG8_BAR;
#undef PG8_SA
#undef PG8_SB
#undef PG8_STAGE
#undef PG8_STAGE2
#undef PG8_STAGEX
#undef PG8_LDA
#undef PG8_LDB
#undef PG8_LDX
#undef PG8_MMA
#undef PG8_MMAX
#undef PG8_WAIT_V
#undef PG8_WAIT_VX
#undef PG8_WAIT_L
#undef PG8_BAR
#undef PG8_SCHED
#undef PG8_PRIO
}
}

__device__ __forceinline__ u32x4 pack8(const f32x4 a, const f32x4 b) { u32x4 w; w.x = cvt_pk_bf16(a[0], a[1]); w.y = cvt_pk_bf16(a[2], a[3]); w.z = cvt_pk_bf16(b[0], b[1]); w.w = cvt_pk_bf16(b[2], b[3]); return w; }
__device__ __forceinline__ void unpack8(const u32x4 w, f32x4& a, f32x4& b) { a = (f32x4){bf_lo(w.x), bf_hi(w.x), bf_lo(w.y), bf_hi(w.y)}; b = (f32x4){bf_lo(w.z), bf_hi(w.z), bf_lo(w.w), bf_hi(w.w)}; }
__device__ __forceinline__ float sumsq8(const f32x4 a, const f32x4 b) { return ((a[0] * a[0] + a[1] * a[1]) + (a[2] * a[2] + a[3] * a[3])) + ((b[0] * b[0] + b[1] * b[1]) + (b[2] * b[2] + b[3] * b[3])); }

struct EpiGateUp {
    bf16_t* act; const float* ssq;
    typedef SsqRegs Regs; static constexpr int BATCH = 5; static constexpr bool HAS_LOADS = true;
    __device__ __forceinline__ void load(int row, const pg8::Unit&, int, int fq, Regs& R) const { ssq_load(ssq, row, fq, R); }
    __device__ __forceinline__ void fin(const f32x4 g0, const f32x4 g1, const f32x4 u0, const f32x4 u1, int row, const pg8::Unit& u, int wc, int fq, const Regs& R) const {
        const float m = msq_from(R), c = __builtin_amdgcn_rsqf(m) * -1.4426950408889634f;
        *(u32x4*)(act + (size_t)row * FF + u.pn * 128 + wc * 32 + 8 * fq) = pack8((g0 * u0) * sigk4(g0 * c, m), (g1 * u1) * sigk4(g1 * c, m));
    }
};
struct EpiResid {
    float* h; bf16_t* hb; float* ssq_out; float scale; const float* src_p; const float* src_s;
    struct Regs { f32x4 h0, h1, h2, h3; }; static constexpr int BATCH = 3; static constexpr bool HAS_LOADS = true;
    __device__ __forceinline__ void load(int row, const pg8::Unit& u, int wc, int fq, Regs& R) const {
        const float* hp = (row < MP ? src_p + (size_t)row * D : src_s + (size_t)(row - MP) * D) + u.pn * 256 + wc * 32 + 8 * fq; R.h0 = *(const f32x4*)hp; R.h1 = *(const f32x4*)(hp + 4); R.h2 = *(const f32x4*)(hp + 128); R.h3 = *(const f32x4*)(hp + 132); }
    __device__ __forceinline__ void fin(const f32x4 a0, const f32x4 a1, const f32x4 b0, const f32x4 b1, int row, const pg8::Unit& u, int wc, int fq, const Regs& R) const {
        const size_t o = (size_t)row * D + u.pn * 256 + wc * 32 + 8 * fq; float* hp = h + o;
        const f32x4 v0 = R.h0 + a0 * scale, v1 = R.h1 + a1 * scale, w0 = R.h2 + b0 * scale, w1 = R.h3 + b1 * scale;
        *(f32x4*)hp = v0; *(f32x4*)(hp + 4) = v1; *(f32x4*)(hp + 128) = w0; *(f32x4*)(hp + 132) = w1;
        *(u32x4*)(hb + o) = pack8(v0, v1); *(u32x4*)(hb + o + 128) = pack8(w0, w1);
        float ss = sumsq8(v0, v1) + sumsq8(w0, w1); ss += __shfl_xor(ss, 16); ss += __shfl_xor(ss, 32);
        if (fq == 0) ssq_out[(size_t)row * 32 + u.pn * 4 + wc] = ss;
    }
};
struct EpiWin {
    bf16_t *ua, *ub, *sga, *sgb; const float* ssq;
    typedef SsqRegs Regs; static constexpr int BATCH = 5; static constexpr bool HAS_LOADS = true;
    __device__ __forceinline__ void load(int row, const pg8::Unit&, int, int fq, Regs& R) const { ssq_load(ssq, row, fq, R); }
    __device__ __forceinline__ void fin(const f32x4 a0, const f32x4 a1, const f32x4 b0, const f32x4 b1, int row, const pg8::Unit& u, int wc, int fq, const Regs& R) const {
        int colt = u.pn * 256; bf16_t* base; int ld; bool sg;
        if (u.pn < 4) { base = ua; ld = SW; sg = false; } else if (u.pn < 8) { base = ub; ld = PW; sg = false; colt -= 1024; }
        else if (u.pn < 16) { base = sga; ld = D; sg = true; colt -= 2048; } else { base = sgb; ld = D; sg = true; colt -= 4096; }
        const float rs = rstd_from(R); f32x4 v0, v1, w0, w1;
        if (sg) { const float c = rs * -1.4426950408889634f; v0 = sigk4(a0 * c, 1.0f); v1 = sigk4(a1 * c, 1.0f); w0 = sigk4(b0 * c, 1.0f); w1 = sigk4(b1 * c, 1.0f); }
        else { v0 = a0 * rs; v1 = a1 * rs; w0 = b0 * rs; w1 = b1 * rs; }
        bf16_t* p = base + (size_t)row * ld + colt + wc * 32 + 8 * fq;
        *(u32x4*)p = pack8(v0, v1); *(u32x4*)(p + 128) = pack8(w0, w1);
    }
};
struct EpiGlu {
    const bf16_t* sga; bf16_t* part;
    struct Regs { u32x4 s; }; static constexpr int BATCH = 9; static constexpr bool HAS_LOADS = true;
    __device__ __forceinline__ void load(int row, const pg8::Unit& u, int wc, int fq, Regs& R) const { R.s = *(const u32x4*)(sga + (size_t)row * D + u.pn * 128 + wc * 32 + 8 * fq); }
    __device__ __forceinline__ void fin(const f32x4 a0, const f32x4 a1, const f32x4 b0, const f32x4 b1, int row, const pg8::Unit& u, int wc, int fq, const Regs& R) const {
        const size_t o = (size_t)row * D + u.pn * 128 + wc * 32 + 8 * fq;
        f32x4 s0, s1; unpack8(R.s, s0, s1);
        *(u32x4*)(part + o) = pack8((s0 * a0) * sigk4(b0 * -1.4426950408889634f, 1.0f), (s1 * a1) * sigk4(b1 * -1.4426950408889634f, 1.0f));
    }
};
struct EpiPoolUp {
    const bf16_t* sgb; const bf16_t* part; bf16_t* mrg;
    struct Regs { u32x4 s0, p0, s1, p1; }; static constexpr int BATCH = 3; static constexpr bool HAS_LOADS = true;
    __device__ __forceinline__ void load(int row, const pg8::Unit& u, int wc, int fq, Regs& R) const {
        const size_t o = (size_t)row * D + u.pn * 256 + wc * 32 + 8 * fq; R.s0 = *(const u32x4*)(sgb + o); R.p0 = *(const u32x4*)(part + o); R.s1 = *(const u32x4*)(sgb + o + 128); R.p1 = *(const u32x4*)(part + o + 128); }
    __device__ __forceinline__ void fin(const f32x4 a0, const f32x4 a1, const f32x4 b0, const f32x4 b1, int row, const pg8::Unit& u, int wc, int fq, const Regs& R) const {
        const size_t o = (size_t)row * D + u.pn * 256 + wc * 32 + 8 * fq;
        f32x4 s0, s1, p0, p1, t0, t1, q0, q1; unpack8(R.s0, s0, s1); unpack8(R.p0, p0, p1); unpack8(R.s1, t0, t1); unpack8(R.p1, q0, q1);
        *(u32x4*)(mrg + o) = pack8(p0 + s0 * a0, p1 + s1 * a1); *(u32x4*)(mrg + o + 128) = pack8(q0 + t0 * b0, q1 + t1 * b1);
    }
};
struct EpiStore {
    bf16_t* out; int ldc;
    struct Regs {}; static constexpr int BATCH = 1; static constexpr bool HAS_LOADS = false;
    __device__ __forceinline__ void load(int, const pg8::Unit&, int, int, Regs&) const {}
    __device__ __forceinline__ void fin(const f32x4 a0, const f32x4 a1, const f32x4 b0, const f32x4 b1, int row, const pg8::Unit& u, int wc, int fq, const Regs&) const {
        bf16_t* p = out + (size_t)row * ldc + u.pn * 256 + wc * 32 + 8 * fq; *(u32x4*)p = pack8(a0, a1); *(u32x4*)(p + 128) = pack8(b0, b1);
    }
};
struct EpiPle {
    float* h; const bf16_t* t1; bf16_t* hb; const float* ssq; float* ssq_out;
    struct Regs { SsqRegs q; f32x4 h0, h1, h2, h3; u32x4 ta, tb; }; static constexpr int BATCH = 2; static constexpr bool HAS_LOADS = true;
    __device__ __forceinline__ void load(int row, const pg8::Unit& u, int wc, int fq, Regs& R) const {
        ssq_load(ssq, row, fq, R.q); const size_t o = (size_t)row * D + u.pn * 256 + wc * 32 + 8 * fq; const float* hp = h + o;
        R.h0 = *(const f32x4*)hp; R.h1 = *(const f32x4*)(hp + 4); R.h2 = *(const f32x4*)(hp + 128); R.h3 = *(const f32x4*)(hp + 132); R.ta = *(const u32x4*)(t1 + o); R.tb = *(const u32x4*)(t1 + o + 128); }
    __device__ __forceinline__ void fin(const f32x4 a0, const f32x4 a1, const f32x4 b0, const f32x4 b1, int row, const pg8::Unit& u, int wc, int fq, const Regs& R) const {
        const float rs = rstd_from(R.q);
        const size_t o = (size_t)row * D + u.pn * 256 + wc * 32 + 8 * fq; float* hp = h + o;
        f32x4 t0, t1v, t2, t3; unpack8(R.ta, t0, t1v); unpack8(R.tb, t2, t3);
        f32x4 v0 = R.h0, v1 = R.h1, w0 = R.h2, w1 = R.h3;
        { const float c = rs * -1.4426950408889634f; v0 += t0 * sigk4(a0 * c, 1.0f); v1 += t1v * sigk4(a1 * c, 1.0f); w0 += t2 * sigk4(b0 * c, 1.0f); w1 += t3 * sigk4(b1 * c, 1.0f); }
        *(f32x4*)hp = v0; *(f32x4*)(hp + 4) = v1; *(f32x4*)(hp + 128) = w0; *(f32x4*)(hp + 132) = w1;
        if (hb) { *(u32x4*)(hb + o) = pack8(v0, v1); *(u32x4*)(hb + o + 128) = pack8(w0, w1); }
        float ss = sumsq8(v0, v1) + sumsq8(w0, w1); ss += __shfl_xor(ss, 16); ss += __shfl_xor(ss, 32);
        if (fq == 0) ssq_out[(size_t)row * 32 + u.pn * 4 + wc] = ss;
    }
};
struct WeffOrder {
    int c;
    __device__ __forceinline__ bool next(int i, pg8::Unit& u) const {
        if (i != 0 || c < 0 || c >= 32) return false;
        const int gi = c >> 3; u.pm = c & 7; u.pn = gi; u.xoff = 0;
        u.aoff = (unsigned)(gi * 512 + (size_t)u.pm * 256 * PW * 2); u.boff = (unsigned)(gi * 131072); return true;
    }
};
struct GluOrder {
    pg8::StaticOrder base;
    __device__ __forceinline__ bool next(int i, pg8::Unit& u) const {
        if (!base.next(i >> 1, u)) return false;
        u.pn = 2 * u.pn + (i & 1); u.boff = (unsigned)u.pn * base.tb; return true;
    }
};
struct EpiWeff {
    bf16_t* weff;
    struct Regs {}; static constexpr int BATCH = 1; static constexpr bool HAS_LOADS = false;
    __device__ __forceinline__ void load(int, const pg8::Unit&, int, int, Regs&) const {}
    __device__ __forceinline__ void fin(const f32x4 a0, const f32x4 a1, const f32x4 b0, const f32x4 b1, int row, const pg8::Unit& u, int wc, int fq, const Regs&) const {
        bf16_t* p = weff + (size_t)row * PW + u.pn * 256 + wc * 32 + 8 * fq;
        *(u32x4*)p = pack8(a0, a1); *(u32x4*)(p + 128) = pack8(b0, b1);
    }
};

#define XB_TMO      128
#define XB_XCNT(j)  (256  + 64 * (j))
#define XB_XSUB(j)  (1280 + 64 * (j))
#define XB_XGEN(j)  (2304 + 64 * (j))
#define XB_TOP      3328
#define XB_TOPGEN   3392
#define XCD_BAR_WORDS 3456
#define XB_SPIN_CAP (1u << 22)
__device__ __forceinline__ unsigned xb_ld(unsigned* p)              { return __hip_atomic_load(p, __ATOMIC_RELAXED, __HIP_MEMORY_SCOPE_AGENT); }
__device__ __forceinline__ unsigned xb_add(unsigned* p, unsigned v) { return __hip_atomic_fetch_add(p, v, __ATOMIC_RELAXED, __HIP_MEMORY_SCOPE_AGENT); }
__device__ __forceinline__ unsigned xb_xcc_id() { return (unsigned)__builtin_amdgcn_s_getreg((3 << 11) | 20) & 0xFu; }
#define XB_SPIN(cond, bar) do { unsigned _sp = 0; while (cond) { __builtin_amdgcn_s_sleep(1); \
    if ((++_sp & 255u) == 0u) { if (xb_ld(&(bar)[XB_TMO])) break; if (_sp > XB_SPIN_CAP) { atomicAdd(&(bar)[XB_TMO], 1u); break; } } } } while (0)
struct XcdBarrier { unsigned* bar; unsigned x; volatile LAS unsigned* st; unsigned G; };
__device__ __forceinline__ XcdBarrier xcd_barrier_post(unsigned* bar, volatile LAS unsigned* st, bool t0, unsigned G) {
    XcdBarrier b; b.bar = bar; b.x = xb_xcc_id(); b.st = st; b.G = G;
    if (t0) (void)xb_add(&bar[XB_XCNT(b.x)], 1u);
    return b;
}
__device__ __forceinline__ void xcd_barrier_complete(unsigned* bar, unsigned x, unsigned& nloc, unsigned& nx, unsigned G) {
    unsigned sum, cnt, mine, sp = 0u;
    for (;;) {
        sum = 0u; cnt = 0u; mine = 0u;
#pragma unroll
        for (unsigned j = 0; j < 16; ++j) { const unsigned c = xb_ld(&bar[XB_XCNT(j)]); sum += c; cnt += (c > 0u) ? 1u : 0u; mine = (j == x) ? c : mine; }
        if (sum == G) break;
        __builtin_amdgcn_s_sleep(1);
        if ((++sp & 255u) == 0u) { if (xb_ld(&bar[XB_TMO])) break; if (sp > XB_SPIN_CAP) { atomicAdd(&bar[XB_TMO], 1u); break; } }
    }
    nloc = mine > 0u ? mine : 1u; nx = cnt > 0u ? cnt : 1u;
}
__device__ __forceinline__ void xcd_barrier_top() { asm volatile("s_waitcnt vmcnt(0)" ::: "memory"); __syncthreads(); }
__device__ __forceinline__ void xcd_barrier_rest(const XcdBarrier& b, bool t0) {
    if (t0) {
        unsigned* bar = b.bar;
        asm volatile("s_waitcnt lgkmcnt(0)" ::: "memory");
        unsigned nloc = b.st[0], nx = b.st[1];
        if (nloc == 0u) { xcd_barrier_complete(bar, b.x, nloc, nx, b.G); b.st[0] = nloc; b.st[1] = nx; }
        const unsigned old = xb_add(&bar[XB_XSUB(b.x)], 1u);
        const unsigned gen = old / nloc;
        if (nx == 1u) {
            __builtin_amdgcn_fence(__ATOMIC_ACQUIRE, "agent");
            XB_SPIN(xb_ld(&bar[XB_XSUB(b.x)]) < (gen + 1u) * nloc, bar);
            asm volatile("s_waitcnt vmcnt(0)" ::: "memory");
        } else if (old + 1u == (gen + 1u) * nloc) {
            __builtin_amdgcn_fence(__ATOMIC_RELEASE, "agent");
            asm volatile("s_waitcnt vmcnt(0)" ::: "memory");
            const unsigned og = xb_add(&bar[XB_TOP], 1u);
            const unsigned tg = og / nx;
            if (og + 1u == (tg + 1u) * nx) xb_add(&bar[XB_TOPGEN], 1u);
            else XB_SPIN(xb_ld(&bar[XB_TOPGEN]) == tg, bar);
            __builtin_amdgcn_fence(__ATOMIC_ACQUIRE, "agent");
            xb_add(&bar[XB_XGEN(b.x)], 1u);
            asm volatile("s_waitcnt vmcnt(0)" ::: "memory");
        } else {
            XB_SPIN(xb_ld(&bar[XB_XGEN(b.x)]) == gen, bar);
            __builtin_amdgcn_fence(__ATOMIC_ACQUIRE, "agent");
            asm volatile("s_waitcnt vmcnt(0)" ::: "memory");
        }
    }
    __syncthreads();
}
__device__ __forceinline__ void xcd_barrier(const XcdBarrier& b, bool t0) { xcd_barrier_top(); xcd_barrier_rest(b, t0); }
struct BarPre { const XcdBarrier& b; bool on, t0;
    __device__ __forceinline__ void top() const { if (on) xcd_barrier_top(); }
    __device__ __forceinline__ void rest() const { if (on) xcd_barrier_rest(b, t0); } };

__device__ __forceinline__ void evt_arrive(unsigned* w, bool t0) {
    asm volatile("s_waitcnt vmcnt(0)" ::: "memory"); __syncthreads();
    if (t0) { __builtin_amdgcn_fence(__ATOMIC_RELEASE, "agent"); asm volatile("s_waitcnt vmcnt(0)" ::: "memory"); (void)xb_add(w, 1u); }
}
__device__ __forceinline__ void evt_arrive_wt(unsigned* w, bool t0) {
    asm volatile("s_waitcnt vmcnt(0)" ::: "memory"); __syncthreads();
    if (t0) (void)xb_add(w, 1u);
}
__device__ __forceinline__ void evt_wait(unsigned* w, unsigned target, unsigned* tmo, bool t0) {
    if (t0) { unsigned sp = 0u;
        while (xb_ld(w) < target) { __builtin_amdgcn_s_sleep(1); if ((++sp & 255u) == 0u) { if (xb_ld(tmo)) break; if (sp > XB_SPIN_CAP) { atomicAdd(tmo, 1u); break; } } }
        __builtin_amdgcn_fence(__ATOMIC_ACQUIRE, "agent"); asm volatile("s_waitcnt vmcnt(0)" ::: "memory"); }
    __syncthreads();
}

struct Args { const float* in[N_IN]; float* out; unsigned char* ws; int ph_lo, ph_hi; };
static_assert(sizeof(Args) == (N_IN + 2) * 8 + 8, "Args has no padding");
typedef const __attribute__((address_space(4))) Args* CArgs;
__device__ __forceinline__ CArgs args_ptr() { CArgs p = (CArgs)__builtin_amdgcn_kernarg_segment_ptr(); asm volatile("" : "+s"(p)); return p; }

constexpr int CT_PITCH = 144;
struct ConvJob { const float* W; bf16_t* WT; const float* gain; int K, N, mode; };
__device__ __forceinline__ void conv_load(const ConvJob& J, int item, int lane, f32x4 (&v)[16], int& k0, int& n0) {
    const int nblk = J.N / 64, kb = item / nblk, nb = item % nblk; k0 = 64 * kb; n0 = 64 * nb;
    const float* src = J.W + (size_t)(k0 + 16 * (lane >> 4)) * J.N + n0 + 4 * (lane & 15);
#pragma unroll
    for (int i = 0; i < 16; ++i) v[i] = *(const f32x4*)(src + (size_t)i * J.N);
    if (J.gain) { const f32x4* gp = (const f32x4*)(J.gain + k0 + 16 * (lane >> 4));
#pragma unroll
        for (int i4 = 0; i4 < 4; ++i4) { const f32x4 gq = gp[i4];
#pragma unroll
            for (int e = 0; e < 4; ++e) v[4 * i4 + e] *= gq[e]; } }
}
__device__ __forceinline__ void conv_store(const ConvJob& J, int k0, int n0, int lane, const f32x4 (&v)[16], LAS unsigned char* img) {
#pragma unroll
    for (int j = 0; j < 4; ++j) { LAS unsigned char* p = img + (4 * (lane & 15) + j) * CT_PITCH + 32 * (lane >> 4);
        u32x4 lo, hi; lo.x = cvt_pk_bf16(v[0][j], v[1][j]); lo.y = cvt_pk_bf16(v[2][j], v[3][j]); lo.z = cvt_pk_bf16(v[4][j], v[5][j]); lo.w = cvt_pk_bf16(v[6][j], v[7][j]);
        hi.x = cvt_pk_bf16(v[8][j], v[9][j]); hi.y = cvt_pk_bf16(v[10][j], v[11][j]); hi.z = cvt_pk_bf16(v[12][j], v[13][j]); hi.w = cvt_pk_bf16(v[14][j], v[15][j]);
        *(LAS u32x4*)p = lo; *(LAS u32x4*)(p + 16) = hi; }
    LDS_WAIT(); asm volatile("" ::: "memory");
#pragma unroll
    for (int jj = 0; jj < 8; ++jj) { const int n = (lane >> 3) + 8 * jj, ng = n0 + n; const int r = J.mode == 0 ? ng : (256 * (ng >> 7) + (J.mode == 2 ? 128 : 0) + (ng & 127));
        const u32x4 o = *(const LAS u32x4*)(img + n * CT_PITCH + 16 * (lane & 7));
        { bf16_t* gp = J.WT + (size_t)r * J.K + k0 + 8 * (lane & 7); asm volatile("global_store_dwordx4 %0, %1, off sc1\n\ts_nop 1" :: "v"(gp), "v"(o) : "memory"); } }
    LDS_WAIT(); asm volatile("" ::: "memory");
}
constexpr int CI_FF = (D / 64) * (FF / 64), CI_DN = (FF / 64) * (D / 64), CI_IN = (D / 64) * (NIN / 64), CI_GL = (SW / 64) * (D / 64), CI_DD = (D / 64) * (D / 64), CI_PL = (PLE / 64) * (D / 64);
constexpr int CI_LAYER = 4 * CI_FF + 2 * CI_DN + CI_IN + 3 * CI_GL + 2 * CI_DD + CI_PL;

__device__ __forceinline__ ConvJob conv_job(CArgs a, unsigned char* ws, int l, int& r) {
    unsigned char* wl = ws + WS_W + (size_t)l * WL; ConvJob J;
#define CJ(cnt, idx, Kk, Nn, dst, md, gidx, gK) if (r < (cnt)) { J.W = a->in[idx] + (size_t)l * (Kk) * (Nn); J.WT = (bf16_t*)(wl + (dst)); J.gain = (gidx) >= 0 ? a->in[(gidx) >= 0 ? (gidx) : 0] + (size_t)l * (gK) : nullptr; J.K = Kk; J.N = Nn; J.mode = md; return J; } r -= (cnt);
    CJ(CI_GL, I_WPU, PW, D, WO_PU, 0, I_PSCALE, PW)
    CJ(CI_FF, I_WG1, D, FF, WO_GU1, 1, I_GF1, D)
    CJ(CI_FF, I_WU1, D, FF, WO_GU1, 2, I_GF1, D)
    CJ(CI_DN, I_WD1, FF, D, WO_D1, 0, -1, 0)
    CJ(CI_IN, I_WIN, D, NIN, WO_IN, 0, I_GMIX, D)
    CJ(CI_GL, I_GLA, SW, D, WO_GLU, 1, -1, 0)
    CJ(CI_GL, I_GLB, SW, D, WO_GLU, 2, -1, 0)
    CJ(CI_DD, I_WOUT, D, D, WO_OUT, 0, -1, 0)
    CJ(CI_FF, I_WG2, D, FF, WO_GU2, 1, I_GF2, D)
    CJ(CI_FF, I_WU2, D, FF, WO_GU2, 2, I_GF2, D)
    CJ(CI_DN, I_WD2, FF, D, WO_D2, 0, -1, 0)
    CJ(CI_DD, I_WPG, D, D, WO_PG, 0, I_GPLE, D)
#undef CJ
    J.W = a->in[I_WPLE] + (size_t)l * PLE * D; J.WT = (bf16_t*)(wl + WO_PLE); J.gain = nullptr; J.K = PLE; J.N = D; J.mode = 0; return J;
}
__device__ __forceinline__ void conv_range(CArgs a, unsigned char* ws, int l, int lo, int hi, int idx, int stride, int lane, LAS unsigned char* img) {
    for (int it = lo + idx; it < hi; it += 2 * stride) {
        const int it2 = it + stride; const bool two = it2 < hi;
        int r1 = it, r2 = two ? it2 : it; const ConvJob J1 = conv_job(a, ws, l, r1), J2 = conv_job(a, ws, l, r2);
        f32x4 v1[16], v2[16]; int k1, n1, k2, n2;
        conv_load(J1, r1, lane, v1, k1, n1); conv_load(J2, r2, lane, v2, k2, n2);
        conv_store(J1, k1, n1, lane, v1, img);
        if (two) conv_store(J2, k2, n2, lane, v2, img);
    }
}
constexpr int CI_SPLIT = CI_GL + 2 * CI_FF + CI_DN + CI_IN;
__device__ __forceinline__ void deferred_convert(int layer, int part, int c128, int wv, LAS unsigned char* lds) {
    if (layer >= DEPTH) return;
    int wave = wv; asm volatile("" : "+s"(wave)); const int lane = lane_id();
    CArgs a = args_ptr(); unsigned char* ws = a->ws;
    const int lo = part ? CI_SPLIT : 0, hi = part ? CI_LAYER : CI_SPLIT;
    const int cut = part ? lo + 9 * 128 * NWAVES : hi;
    conv_range(a, ws, layer, lo, cut, c128 * NWAVES + wave, 128 * NWAVES, lane, lds + wave * (64 * CT_PITCH));
    if (part && c128 >= 32) conv_range(a, ws, layer, cut, hi, (c128 - 32) * NWAVES + wave, 96 * NWAVES, lane, lds + wave * (64 * CT_PITCH));
}
__device__ __forceinline__ void prologue_phase(LAS unsigned char* lds, int wv) {
    int wave = wv, G = gridDim.x, bx = blockIdx.x; asm volatile("" : "+s"(wave), "+s"(G), "+s"(bx));
    int tid = TID_FROM(wave); asm volatile("" : "+v"(tid)); const int lane = tid & 63;
    const int vcu = (G % 8 == 0) ? (bx % 8) * (G / 8) + bx / 8 : bx;
    CArgs a = args_ptr(); unsigned char* ws = a->ws;
    const int gw = vcu * NWAVES + wave, NGW = G * NWAVES;
    conv_range(a, ws, 0, 0, CI_SPLIT, gw, NGW, lane, lds + wave * (64 * CT_PITCH));
    __syncthreads();
    for (int it = gw; it < DEPTH * 1024; it += NGW) {
        const int l = it >> 10, e = (it & 1023) * 256 + lane * 4;
        const f32x4 v = *(const f32x4*)(a->in[I_WPOOL] + (size_t)l * 262144 + e);
        u32x2 o; o.x = cvt_pk_bf16(v[0], v[1]); o.y = cvt_pk_bf16(v[2], v[3]);
        *(u32x2*)((bf16_t*)(ws + WS_W + (size_t)l * WL + WO_POOL) + e) = o;
    }
    for (int it = gw; it < DEPTH * M; it += NGW) {
        const int l = it / M, m = it % M;
        const float* src = m < MP ? a->in[I_PP] + ((size_t)l * MP + m) * PLE : a->in[I_PS] + ((size_t)l * MS + (m - MP)) * PLE;
        const f32x4 v = *(const f32x4*)(src + lane * 4);
        u32x2 o; o.x = cvt_pk_bf16(v[0], v[1]); o.y = cvt_pk_bf16(v[2], v[3]);
        *(u32x2*)((bf16_t*)(ws + WS_PB) + ((size_t)l * M + m) * PLE + lane * 4) = o;
    }
    for (int m = gw; m < M; m += NGW) {
        const float* src = m < MP ? a->in[I_XP] + (size_t)m * D : a->in[I_XS] + (size_t)(m - MP) * D;
        bf16_t* hb = (bf16_t*)(ws + WS_HB0) + (size_t)m * D;
        float s = 0.f;
#pragma unroll
        for (int j = 0; j < 8; ++j) { const f32x4 v = *(const f32x4*)(src + j * 256 + lane * 4);
            u32x2 o; o.x = cvt_pk_bf16(v[0], v[1]); o.y = cvt_pk_bf16(v[2], v[3]); *(u32x2*)(hb + j * 256 + lane * 4) = o;
            s += (v[0] * v[0] + v[1] * v[1]) + (v[2] * v[2] + v[3] * v[3]); }
        s += __shfl_xor(s, 32);
        if (lane < 32) ((float*)(ws + WS_SSQ))[(size_t)m * 32 + lane] = s;
    }
}

__device__ __forceinline__ float gelu_tanh(float x) {
    const float z = 1.5957691216057308f * (x + 0.044715f * x * x * x); return x * sigmoid_f(z);
}
struct SsmCtx {
    bf16x8 bfr[2][2];
    bf16x8 cfr[4];
    float lre, lim;
    float dv[4];
};
constexpr int S_PITCH = 136;
template <int MODE>
__device__ __forceinline__ void ssm_chunk(const SsmCtx& cx, const LAS unsigned char* ut, bf16_t* ya, int row0, int g, int lane, float& sre, float& sim, LAS bf16_t* simg,
                                          const float* st_in_re, const float* st_in_im, float* st_out_re, float* st_out_im) {
    const bf16x8 af = *(const LAS bf16x8*)(ut + 32 * (lane & 31) + 16 * (lane >> 5));
    u32x2 uw[2] = {};
    if (MODE != 0) {
#pragma unroll
        for (int tb = 0; tb < 2; ++tb) uw[tb] = *(const LAS u32x2*)(ut + 32 * (16 * tb + (lane & 15)) + 8 * (lane >> 4));
    }
    f32x16 xr0 = {}, xr1 = {}, xi0 = {}, xi1 = {};
    xr0 = __builtin_amdgcn_mfma_f32_32x32x16_bf16(af, cx.bfr[0][0], xr0, 0, 0, 0);
    xr1 = __builtin_amdgcn_mfma_f32_32x32x16_bf16(af, cx.bfr[0][1], xr1, 0, 0, 0);
    xi0 = __builtin_amdgcn_mfma_f32_32x32x16_bf16(af, cx.bfr[1][0], xi0, 0, 0, 0);
    xi1 = __builtin_amdgcn_mfma_f32_32x32x16_bf16(af, cx.bfr[1][1], xi1, 0, 0, 0);
    asm volatile("s_nop 15\n\ts_nop 15\n\ts_nop 15\n\ts_nop 15\n\ts_nop 15\n\ts_nop 15\n\ts_nop 15\n\ts_nop 15" : "+v"(xr0), "+v"(xr1), "+v"(xi0), "+v"(xi1));
#pragma unroll
    for (int r = 0; r < 16; ++r) {
        auto s1 = __builtin_amdgcn_permlane32_swap(__float_as_uint(xr0[r]), __float_as_uint(xr1[r]), false, false); xr0[r] = __uint_as_float(s1[0]); xr1[r] = __uint_as_float(s1[1]);
        auto s2 = __builtin_amdgcn_permlane32_swap(__float_as_uint(xi0[r]), __float_as_uint(xi1[r]), false, false); xi0[r] = __uint_as_float(s2[0]); xi1[r] = __uint_as_float(s2[1]);
    }
    float inr[4], ini[4];
    if (MODE == 2) {
#pragma unroll
        for (int q = 0; q < 4; ++q) { inr[q] = st_in_re[(size_t)q * NG * NP]; ini[q] = st_in_im[(size_t)q * NG * NP]; }
    }
#pragma unroll
    for (int t = 0; t < 32; ++t) {
        const int r = (t & 3) + 4 * (t >> 3); const bool hi = (t & 4) != 0;
        const float xr = hi ? xr1[r] : xr0[r], xi = hi ? xi1[r] : xi0[r];
        if (MODE == 2 && (t & 7) == 0) { sre = inr[t >> 3]; sim = ini[t >> 3]; }
        const float nr = __builtin_fmaf(cx.lre, sre, __builtin_fmaf(-cx.lim, sim, xr)), ni = __builtin_fmaf(cx.lre, sim, __builtin_fmaf(cx.lim, sre, xi));
        sre = nr; sim = ni;
        if (MODE != 0) *(LAS unsigned*)(simg + t * S_PITCH + 2 * lane) = cvt_pk_bf16(sre, sim);
        if (MODE == 2 && (t & 7) == 7) { st_out_re[(size_t)(t >> 3) * NG * NP] = sre; st_out_im[(size_t)(t >> 3) * NG * NP] = sim; }
    }
    if (MODE != 0) {
        LDS_WAIT(); asm volatile("" ::: "memory");
#pragma unroll
        for (int tb = 0; tb < 2; ++tb) {
            f32x4 y = {0.f, 0.f, 0.f, 0.f};
#pragma unroll
            for (int ks = 0; ks < 4; ++ks) { const bf16x8 sf = *(const LAS bf16x8*)(simg + (16 * tb + (lane & 15)) * S_PITCH + 32 * ks + 8 * (lane >> 4));
                y = __builtin_amdgcn_mfma_f32_16x16x32_bf16(cx.cfr[ks], sf, y, 0, 0, 0); }
            asm volatile("s_nop 15\n\ts_nop 15\n\ts_nop 15\n\ts_nop 15" : "+v"(y));
            const size_t o = (size_t)(row0 + 16 * tb + (lane & 15)) * SW + 16 * g + 4 * (lane >> 4);
            const float u0 = bf_lo(uw[tb].x), u1 = bf_hi(uw[tb].x), u2 = bf_lo(uw[tb].y), u3 = bf_hi(uw[tb].y);
            u32x2 ow; ow.x = cvt_pk_bf16(gelu_tanh(y[0] + cx.dv[0] * u0), gelu_tanh(y[1] + cx.dv[1] * u1)); ow.y = cvt_pk_bf16(gelu_tanh(y[2] + cx.dv[2] * u2), gelu_tanh(y[3] + cx.dv[3] * u3));
            *(u32x2*)(ya + o) = ow;
        }
        LDS_WAIT(); asm volatile("" ::: "memory");
    }
}

template <int W> __device__ __forceinline__ void pool_prompt(const bf16_t* base, bf16_t* mo, int t0) {
    unsigned z[W - 1 + 32];
#pragma unroll
    for (int i = 0; i < W - 1 + 32; ++i) { const int j = t0 - (W - 1) + i; z[i] = (i >= W - 1 || t0 > 0) ? *(const unsigned*)(base + (ptrdiff_t)j * PW) : 0u; }
    float r0 = 0.f, r1 = 0.f;
#pragma unroll
    for (int i = 0; i < W - 1; ++i) { r0 += bf_lo(z[i]); r1 += bf_hi(z[i]); }
#pragma unroll
    for (int t = 0; t < 32; ++t) {
        const float z0 = bf_lo(z[W - 1 + t]), z1 = bf_hi(z[W - 1 + t]), w0 = r0 + z0, w1 = r1 + z1;
        const float ic = (t + 1 < W) ? (t0 > 0 ? 1.0f / W : 1.0f / (t + 1)) : 1.0f / W;
        *(unsigned*)(mo + (size_t)t * PW) = cvt_pk_bf16(w0 * ic - z0, w1 * ic - z1);
        r0 = w0 - bf_lo(z[t]); r1 = w1 - bf_hi(z[t]);
    }
}
template <int W> __device__ __forceinline__ void pool_sample(const bf16_t* base, const float* prev, bf16_t* mo) {
    float h0[W - 1], h1[W - 1]; unsigned z[DS];
#pragma unroll
    for (int i = 0; i < W - 1; ++i) { const f32x2 v = *(const f32x2*)(prev + (size_t)(PBUF - (W - 1) + i) * PW); h0[i] = v.x; h1[i] = v.y; }
#pragma unroll
    for (int t = 0; t < DS; ++t) z[t] = *(const unsigned*)(base + (size_t)t * PW);
    float r0 = 0.f, r1 = 0.f;
#pragma unroll
    for (int i = 0; i < W - 1; ++i) { r0 += h0[i]; r1 += h1[i]; }
#pragma unroll
    for (int t = 0; t < DS; ++t) {
        const float z0 = bf_lo(z[t]), z1 = bf_hi(z[t]), w0 = r0 + z0, w1 = r1 + z1;
        *(unsigned*)(mo + (size_t)t * PW) = cvt_pk_bf16(w0 * (1.0f / W) - z0, w1 * (1.0f / W) - z1);
        const int jo = t - (W - 1);
        const float o0 = jo >= 0 ? bf_lo(z[jo >= 0 ? jo : 0]) : h0[jo < 0 ? t : 0], o1 = jo >= 0 ? bf_hi(z[jo >= 0 ? jo : 0]) : h1[jo < 0 ? t : 0];
        r0 = w0 - o0; r1 = w1 - o1;
    }
}
__device__ __forceinline__ void ssm_part(int layer, LAS unsigned char* lds, int wv) {
    int wave = wv, G = gridDim.x, bx = blockIdx.x; asm volatile("" : "+s"(wave), "+s"(G), "+s"(bx));
    int tid = TID_FROM(wave); asm volatile("" : "+v"(tid)); const int lane = tid & 63;
    CArgs a = args_ptr(); unsigned char* ws = a->ws;
    const bf16_t* ua = (const bf16_t*)(ws + WS_UA); const bf16_t* ub = (const bf16_t*)(ws + WS_UB);
    bf16_t* ya = (bf16_t*)(ws + WS_YA); bf16_t* mix = (bf16_t*)(ws + WS_MIX);
    LAS float* E = (LAS float*)lds;
    LAS bf16_t* simg = (LAS bf16_t*)(lds + 4096 + wave * (32 * S_PITCH * 2));
    LAS unsigned char* utile = lds + 4096 + NWAVES * (32 * S_PITCH * 2) + wave * 9216;
    static_assert(4096 + NWAVES * (32 * S_PITCH * 2) + NWAVES * 9216 <= LDSCTL_OFF, "S5 phase LDS map");
    for (int unit = 0; unit < 1; ++unit) {
        const int sq = (bx & 7) >> 1, g = ((bx >> 3) << 1) | (bx & 1);
        SsmCtx cx;
        {
            const float dt = expf(a->in[I_LDT][layer * NG + g]);
            const float are = a->in[I_ARE][((size_t)layer * NG + g) * NP + lane], aim = a->in[I_AIM][((size_t)layer * NG + g) * NP + lane];
            const float mag = expf(are * dt); float sn, cs; sincosf(aim * dt, &sn, &cs);
            cx.lre = mag * cs; cx.lim = mag * sn;
            const float den = are * are + aim * aim, nre = cx.lre - 1.0f;
            const float kre = (nre * are + cx.lim * aim) / den, kim = (cx.lim * are - nre * aim) / den;
#pragma unroll
            for (int q = 0; q < 2; ++q) {
                const int pp = 32 * q + (lane & 31); const float kr = __shfl(kre, pp), ki = __shfl(kim, pp);
                const size_t bo = (((size_t)layer * NG + g) * NP + pp) * NH + 8 * (lane >> 5);
                const f32x4 br0 = *(const f32x4*)(a->in[I_BRE] + bo), br1 = *(const f32x4*)(a->in[I_BRE] + bo + 4), bi0 = *(const f32x4*)(a->in[I_BIM] + bo), bi1 = *(const f32x4*)(a->in[I_BIM] + bo + 4);
                const u32x4 wre = pack8(br0 * kr - bi0 * ki, br1 * kr - bi1 * ki), wim = pack8(bi0 * kr + br0 * ki, bi1 * kr + br1 * ki);
                cx.bfr[0][q] = __builtin_bit_cast(bf16x8, wre); cx.bfr[1][q] = __builtin_bit_cast(bf16x8, wim);
            }
#pragma unroll
            for (int ks = 0; ks < 4; ++ks) {
                const int h = lane & 15, p0 = 16 * ks + 4 * (lane >> 4); const size_t co = (((size_t)layer * NG + g) * NH + h) * NP + p0;
                const f32x4 cr = *(const f32x4*)(a->in[I_CRE] + co), ci = *(const f32x4*)(a->in[I_CIM] + co);
                cx.cfr[ks] = __builtin_bit_cast(bf16x8, pack8((f32x4){cr[0], -ci[0], cr[1], -ci[1]}, (f32x4){cr[2], -ci[2], cr[3], -ci[3]}));
            }
#pragma unroll
            for (int i = 0; i < 4; ++i) cx.dv[i] = a->in[I_SD][((size_t)layer * NG + g) * NH + 4 * (lane >> 4) + i];
        }
        const int rowp = sq * SEQ + wave * 256, s0 = 32 * sq + 4 * wave;
        {
            bf16x8 tl[9];
#pragma unroll
            for (int c = 0; c < 9; ++c) tl[c] = *(const bf16x8*)(ua + (size_t)((c < 8 ? rowp + 32 * c : MP + s0 * DS) + (lane & 31)) * SW + 16 * g + 8 * (lane >> 5));
#pragma unroll
            for (int c = 0; c < 9; ++c) *(LAS bf16x8*)(utile + 1024 * c + 32 * (lane & 31) + 16 * (lane >> 5)) = tl[c];
            LDS_WAIT(); asm volatile("" ::: "memory");
        }
        float sre = 0.f, sim = 0.f;
        for (int c = 0; c < 8; ++c) ssm_chunk<0>(cx, utile + 1024 * c, ya, rowp + 32 * c, g, lane, sre, sim, simg, nullptr, nullptr, nullptr, nullptr);
        E[(wave * 64 + lane) * 2] = sre; E[(wave * 64 + lane) * 2 + 1] = sim;
        LDS_WAIT(); __syncthreads();
        float pr = cx.lre, pi = cx.lim;
#pragma unroll
        for (int i = 0; i < 8; ++i) { const float nr = pr * pr - pi * pi, ni = 2.f * pr * pi; pr = nr; pi = ni; }
        sre = 0.f; sim = 0.f;
        for (int v = 0; v < wave; ++v) { const float er = E[(v * 64 + lane) * 2], ei = E[(v * 64 + lane) * 2 + 1]; const float nr = pr * sre - pi * sim + er, ni = pr * sim + pi * sre + ei; sre = nr; sim = ni; }
        for (int c = 0; c < 8; ++c) ssm_chunk<1>(cx, utile + 1024 * c, ya, rowp + 32 * c, g, lane, sre, sim, simg, nullptr, nullptr, nullptr, nullptr);
        if (wave == 7) { a->out[O_SRP + (((size_t)layer * NB + sq) * NG + g) * NP + lane] = sre; a->out[O_SIP + (((size_t)layer * NB + sq) * NG + g) * NP + lane] = sim; }
        {
            const size_t so = (((size_t)layer * DB + s0) * NG + g) * NP + lane;
            float tr = 0.f, ti = 0.f;
            ssm_chunk<2>(cx, utile + 1024 * 8, ya, MP + s0 * DS, g, lane, tr, ti, simg, a->in[I_SRE] + so, a->in[I_SIM] + so, a->out + O_SRS + so, a->out + O_SIS + so);
        }
        __syncthreads();
    }
}
__device__ __forceinline__ void pool_part(int layer, int wv) {
    int wave = wv, G = gridDim.x, bx = blockIdx.x; asm volatile("" : "+s"(wave), "+s"(G), "+s"(bx));
    int tid = TID_FROM(wave); asm volatile("" : "+v"(tid)); const int lane = tid & 63;
    CArgs a = args_ptr(); unsigned char* ws = a->ws;
    const bf16_t* ua = (const bf16_t*)(ws + WS_UA); const bf16_t* ub = (const bf16_t*)(ws + WS_UB);
    bf16_t* ya = (bf16_t*)(ws + WS_YA); bf16_t* mix = (bf16_t*)(ws + WS_MIX);
    const int pair = (bx & 7) >> 1, pj = ((bx >> 3) << 1) | (bx & 1);
    const int gw = pj * NWAVES + wave, NGW = 64 * NWAVES;
    for (int it = gw; it < 64 * 8; it += NGW) {
        const int cb = it & 7, ts = (it >> 3) & 63, b = pair; const int c = cb * 128 + 2 * lane, t0 = ts * 32;
        const bf16_t* base = ub + (size_t)b * SEQ * PW + c; bf16_t* mo = mix + ((size_t)b * SEQ + t0) * PW + c;
        switch (cb >> 1) { case 0: pool_prompt<2>(base, mo, t0); break; case 1: pool_prompt<4>(base, mo, t0); break; case 2: pool_prompt<8>(base, mo, t0); break; default: pool_prompt<16>(base, mo, t0); break; }
    }
    for (int it = gw; it < 32 * 8; it += NGW) {
        const int cb = it & 7, b = 32 * pair + (it >> 3); const int c = cb * 128 + 2 * lane;
        const bf16_t* base = ub + ((size_t)MP + b * DS) * PW + c; const float* prev = a->in[I_SPOOL] + (((size_t)layer * DB + b) * PBUF) * PW + c; bf16_t* mo = mix + ((size_t)MP + b * DS) * PW + c;
        switch (cb >> 1) { case 0: pool_sample<2>(base, prev, mo); break; case 1: pool_sample<4>(base, prev, mo); break; case 2: pool_sample<8>(base, prev, mo); break; default: pool_sample<16>(base, prev, mo); break; }
    }
    const int gt = pj * NTHREADS + tid, NGT = 64 * NTHREADS;
    for (int e = gt; e < PBUF * (PW / 4); e += NGT) {
        const int c4 = e & 255, r = (e >> 8) % PBUF, b = pair;
        const u32x2 z = *(const u32x2*)(ub + ((size_t)b * SEQ + (SEQ - PBUF) + r) * PW + 4 * c4);
        *(f32x4*)(a->out + O_PP + (((size_t)layer * NB + b) * PBUF + r) * PW + 4 * c4) = (f32x4){bf_lo(z.x), bf_hi(z.x), bf_lo(z.y), bf_hi(z.y)};
    }
    for (int e = gt; e < 32 * PBUF * (PW / 4); e += NGT) {
        const int c4 = e & 255, r = (e >> 8) % PBUF, b = 32 * pair + (e >> 8) / PBUF; f32x4 v;
        if (r < PBUF - DS) v = *(const f32x4*)(a->in[I_SPOOL] + (((size_t)layer * DB + b) * PBUF + DS + r) * PW + 4 * c4);
        else { const u32x2 z = *(const u32x2*)(ub + ((size_t)MP + b * DS + (r - (PBUF - DS))) * PW + 4 * c4); v = (f32x4){bf_lo(z.x), bf_hi(z.x), bf_lo(z.y), bf_hi(z.y)}; }
        *(f32x4*)(a->out + O_PS + (((size_t)layer * DB + b) * PBUF + r) * PW + 4 * c4) = v;
    }
}

__device__ __forceinline__ void final_phase(int wv) {
    int wave = wv, G = gridDim.x, bx = blockIdx.x; asm volatile("" : "+s"(wave), "+s"(G), "+s"(bx));
    int tid = TID_FROM(wave); asm volatile("" : "+v"(tid)); const int lane = tid & 63;
    CArgs a = args_ptr(); const float* h = (const float*)(a->ws + WS_H); const float* ssq = (const float*)(a->ws + WS_SSQ);
    const int pair = (bx & 7) >> 1, pj = ((bx >> 3) << 1) | (bx & 1);
    const int gw = pj * NWAVES + wave, NGW = 64 * NWAVES;
    for (int r = gw; r < SEQ + 32 * DS; r += NGW) {
        const int m = r < SEQ ? pair * SEQ + r : MP + pair * (32 * DS) + (r - SEQ);
        const float s = wave_sum(lane < 32 ? ssq[(size_t)m * 32 + lane] : 0.f);
        const float rs = __builtin_amdgcn_rsqf(s * (1.0f / D) + RMS_EPS);
#pragma unroll
        for (int j = 0; j < 8; ++j) { const f32x4 v = *(const f32x4*)(h + (size_t)m * D + j * 256 + lane * 4), gn = *(const f32x4*)(a->in[I_GFIN] + j * 256 + lane * 4);
            *(f32x4*)(a->out + O_Y + (size_t)m * D + j * 256 + lane * 4) = v * rs * gn; }
    }
}

constexpr int PH_PER_LAYER = 10, PH_LAYER0 = 2, PH_FINAL = PH_LAYER0 + DEPTH * PH_PER_LAYER, N_PHASES = PH_FINAL + 1;

__global__ void __launch_bounds__(NTHREADS, 2) fwd(Args args) {
    extern __shared__ __attribute__((aligned(16))) unsigned char lds_raw[];
    LAS unsigned char* lds = (LAS unsigned char*)lds_raw;
    volatile LAS unsigned* MISC = (volatile LAS unsigned*)(lds + MISC_OFF);
    const int tid = threadIdx.x; const int wave0 = __builtin_amdgcn_readfirstlane(tid >> 6);
    const int G0 = gridDim.x; const int bx0 = blockIdx.x;
    for (int u = tid; u < (LDS_BYTES - LDSCTL_OFF) / 4; u += NTHREADS) ((LAS unsigned*)(lds + LDSCTL_OFF))[u] = 0u;
    __syncthreads();
    const int lo = args.ph_lo, hi = args.ph_hi;
    XcdBarrier bar; bar.bar = (unsigned*)(args.ws + WS_CTL) + CW_BAR; bar.x = 0; bar.st = nullptr; bar.G = (unsigned)G0;
    XcdBarrier gbar = bar, pbar = bar;
    if (hi - lo > 1) { bar = xcd_barrier_post((unsigned*)(args.ws + WS_CTL) + CW_BAR, MISC + 8, tid == 0, (unsigned)G0);
        gbar = xcd_barrier_post((unsigned*)(args.ws + WS_CTL) + 4096 * (1 + (bx0 & 7)), MISC + 10, tid == 0, (unsigned)(G0 / 8));
        pbar = xcd_barrier_post((unsigned*)(args.ws + WS_CTL) + 4096 * (9 + ((bx0 & 7) >> 1)), MISC + 12, tid == 0, (unsigned)(G0 / 4)); }
#define EVT(e) ((unsigned*)(args_ptr()->ws + WS_CTL) + 4096 * 13 + 64 * (e))
#define EVT_TMO ((unsigned*)(args_ptr()->ws + WS_CTL) + CW_BAR + XB_TMO)
#define IN(k) (lo <= (k) && (k) < hi)
#define SEAM(k) do { if (IN((k) + 1)) xcd_barrier(bar, TID_FROM(wave0) == 0); } while (0)
#define SEAML(k) do { if (IN((k) + 1)) xcd_barrier(gbar, TID_FROM(wave0) == 0); } while (0)
#define SEAMP(k) do { if (IN((k) + 1)) xcd_barrier(pbar, TID_FROM(wave0) == 0); } while (0)
#define WSP() unsigned char* ws = args_ptr()->ws; int G = G0, bx = bx0; asm volatile("" : "+s"(G), "+s"(bx))

    if (IN(0)) { prologue_phase(lds, wave0); SEAM(1); }
    for (int layer = 0; layer < DEPTH; ++layer) {
        const int pb = PH_LAYER0 + layer * PH_PER_LAYER;
#define LAYER_PTRS() WSP(); unsigned char* wl = ws + WS_W + (size_t)layer * WL; float* H = (float*)(ws + WS_H); \
        bf16_t* hb_cur = (bf16_t*)(ws + ((layer & 1) ? WS_HB1 : WS_HB0)); bf16_t* hb_nxt = (bf16_t*)(ws + ((layer & 1) ? WS_HB0 : WS_HB1)); \
        float* ssq0 = (float*)(ws + WS_SSQ); float* ssq1 = ssq0 + (size_t)M * 32; bf16_t* act = (bf16_t*)(ws + WS_ACT); \
        (void)wl; (void)H; (void)hb_cur; (void)hb_nxt; (void)ssq0; (void)ssq1; (void)act
        if (IN(pb + 0)) { if (layer > 0 && hi - lo > 1) evt_wait(EVT(2 * layer), 128u, EVT_TMO, TID_FROM(wave0) == 0);
            LAYER_PTRS();
            pg8::Gemm g{hb_cur, (const bf16_t*)(wl + WO_GU1), D, D, D, ws}; pg8::StaticOrder S; S.init(MP, 2 * FF, D, D, G, bx);
            EpiGateUp E{act, ssq0}; pg8::gemm_phase<EpiGateUp, pg8::StaticOrder, true, BarPre>(lds, g, S, E, wave0, BarPre{gbar, layer > 0 && IN(pb - 1), TID_FROM(wave0) == 0});
            if (bx >= 128) { deferred_convert(layer, 1, bx - 128, wave0, lds); __syncthreads(); if (hi - lo > 1) evt_arrive_wt(EVT(2 * layer + 1), TID_FROM(wave0) == 0); }
            if (bx >= 128 && bx < 160) {
                pg8::Gemm g2{(const bf16_t*)(wl + WO_PU), (const bf16_t*)(wl + WO_POOL), PW, 256, 256, ws}; WeffOrder S2{bx - 128}; EpiWeff E2{(bf16_t*)(wl + WO_EFF)};
                pg8::gemm_phase<EpiWeff, WeffOrder, false>(lds, g2, S2, E2, wave0);
                if (hi - lo > 1) evt_arrive(EVT(8 + layer), TID_FROM(wave0) == 0);
            }
        }
        if (IN(pb + 1)) { LAYER_PTRS();
            pg8::Gemm g{act, (const bf16_t*)(wl + WO_D1), FF, FF, FF, ws}; pg8::StaticOrder S; S.init(MP, D, FF, FF, G, bx);
            EpiResid E{H, hb_cur, ssq1, 0.5f, layer == 0 ? args_ptr()->in[I_XP] : H, layer == 0 ? args_ptr()->in[I_XS] : H + (size_t)MP * D};
            pg8::gemm_phase<EpiResid, pg8::StaticOrder, true, BarPre>(lds, g, S, E, wave0, BarPre{gbar, IN(pb + 0), TID_FROM(wave0) == 0});
        }
        if (IN(pb + 2)) { LAYER_PTRS();
            pg8::Gemm g{hb_cur, (const bf16_t*)(wl + WO_IN), D, D, D, ws}; pg8::StaticOrder S; S.init(MP, NIN, D, D, G, bx);
            EpiWin E{(bf16_t*)(ws + WS_UA), (bf16_t*)(ws + WS_UB), (bf16_t*)(ws + WS_SGA), (bf16_t*)(ws + WS_SGB), ssq1};
            pg8::gemm_phase<EpiWin, pg8::StaticOrder, true, BarPre>(lds, g, S, E, wave0, BarPre{gbar, IN(pb + 1), TID_FROM(wave0) == 0}); SEAMP(pb + 2);
        }
        if (IN(pb + 3)) { ssm_part(layer, lds, wave0); pool_part(layer, wave0); SEAMP(pb + 3); }
        if (IN(pb + 4) && hi - lo > 1) { evt_wait(EVT(2 * layer + 1), 128u, EVT_TMO, TID_FROM(wave0) == 0); evt_wait(EVT(8 + layer), 32u, EVT_TMO, TID_FROM(wave0) == 0); }
        if (IN(pb + 4)) {
            { LAYER_PTRS(); pg8::Gemm g{(const bf16_t*)(ws + WS_YA), (const bf16_t*)(wl + WO_GLU), SW, SW, SW, ws}; GluOrder S; S.base.init(MP, D, SW, SW, G, bx);
              EpiGlu E{(const bf16_t*)(ws + WS_SGA), (bf16_t*)(ws + WS_PART)}; pg8::gemm_phase<EpiGlu, GluOrder, true>(lds, g, S, E, wave0); }
            { LAYER_PTRS(); pg8::Gemm g{(const bf16_t*)(ws + WS_MIX), (const bf16_t*)(wl + WO_EFF), PW, PW, PW, ws}; pg8::StaticOrder S; S.init(MP, D, PW, PW, G, bx);
              EpiPoolUp E{(const bf16_t*)(ws + WS_SGB), (const bf16_t*)(ws + WS_PART), (bf16_t*)(ws + WS_MRG)}; pg8::gemm_phase<EpiPoolUp, pg8::StaticOrder, true>(lds, g, S, E, wave0); }
        }
        if (IN(pb + 6)) { LAYER_PTRS();
            pg8::Gemm g{(const bf16_t*)(ws + WS_MRG), (const bf16_t*)(wl + WO_OUT), D, D, D, ws}; pg8::StaticOrder S; S.init(MP, D, D, D, G, bx);
            EpiResid E{H, hb_cur, ssq0, 1.0f, H, H + (size_t)MP * D}; pg8::gemm_phase<EpiResid, pg8::StaticOrder, true, BarPre>(lds, g, S, E, wave0, BarPre{gbar, IN(pb + 4), TID_FROM(wave0) == 0});
        }
        if (IN(pb + 7)) { LAYER_PTRS();
            pg8::Gemm g{hb_cur, (const bf16_t*)(wl + WO_GU2), D, D, D, ws}; pg8::StaticOrder S; S.init(MP, 2 * FF, D, D, G, bx);
            EpiGateUp E{act, ssq0}; pg8::gemm_phase<EpiGateUp, pg8::StaticOrder, true, BarPre>(lds, g, S, E, wave0, BarPre{gbar, IN(pb + 6), TID_FROM(wave0) == 0});
            if (bx >= 128) { deferred_convert(layer + 1, 0, bx - 128, wave0, lds); if (layer + 1 < DEPTH && hi - lo > 1) evt_arrive_wt(EVT(2 * (layer + 1)), TID_FROM(wave0) == 0); }
        }
        if (IN(pb + 8)) { LAYER_PTRS();
            pg8::Gemm g{act, (const bf16_t*)(wl + WO_D2), FF, FF, FF, ws}; pg8::StaticOrder S; S.init(MP, D, FF, FF, G, bx);
            EpiResid E{H, hb_cur, ssq1, 0.5f, H, H + (size_t)MP * D}; pg8::gemm_phase<EpiResid, pg8::StaticOrder, true, BarPre>(lds, g, S, E, wave0, BarPre{gbar, IN(pb + 7), TID_FROM(wave0) == 0});
        }
        if (IN(pb + 9)) {
            { LAYER_PTRS(); pg8::Gemm g{(const bf16_t*)(ws + WS_PB) + (size_t)layer * M * PLE, (const bf16_t*)(wl + WO_PLE), PLE, PLE, PLE, ws}; pg8::StaticOrder S; S.init(MP, D, PLE, PLE, G, bx);
              EpiStore E{(bf16_t*)(ws + WS_T1), D}; pg8::gemm_phase<EpiStore, pg8::StaticOrder, true, BarPre>(lds, g, S, E, wave0, BarPre{gbar, IN(pb + 8), TID_FROM(wave0) == 0}); }
            { LAYER_PTRS(); pg8::Gemm g{hb_cur, (const bf16_t*)(wl + WO_PG), D, D, D, ws}; pg8::StaticOrder S; S.init(MP, D, D, D, G, bx);
              EpiPle E{H, (const bf16_t*)(ws + WS_T1), layer + 1 < DEPTH ? hb_nxt : nullptr, ssq1, ssq0}; pg8::gemm_phase<EpiPle, pg8::StaticOrder, true>(lds, g, S, E, wave0); }
            if (layer + 1 == DEPTH) SEAMP(pb + 9);
        }
    }
    if (IN(PH_FINAL)) final_phase(wave0);
#undef IN
#undef SEAM
#undef SEAML
#undef SEAMP
}

extern "C" void kernel_launch(void* const* d_in, const int* in_sizes, int n_in, void* d_out, int out_size, void* d_ws, size_t ws_size, hipStream_t stream) {
    static int grid = 0;
    if (grid == 0) {
        if (n_in != N_IN || (size_t)out_size != O_END || ws_size < WS_END) { fprintf(stderr, "kernel_launch: unexpected shapes: n_in %d out %d ws %zu (need %zu)\n", n_in, out_size, ws_size, (size_t)WS_END); grid = -1; return; }
        int dev = 0, cus = 0, per_cu = 0;
        if (hipGetDevice(&dev) != hipSuccess || hipDeviceGetAttribute(&cus, hipDeviceAttributeMultiprocessorCount, dev) != hipSuccess) { grid = -1; return; }
        if (hipFuncSetAttribute((const void*)fwd, hipFuncAttributeMaxDynamicSharedMemorySize, LDS_BYTES) != hipSuccess) { fprintf(stderr, "kernel_launch: hipFuncSetAttribute failed\n"); grid = -1; return; }
        if (hipOccupancyMaxActiveBlocksPerMultiprocessor(&per_cu, (const void*)fwd, NTHREADS, LDS_BYTES) != hipSuccess || per_cu < 1) fprintf(stderr, "kernel_launch: occupancy query reports %d\n", per_cu);
        (void)hipGetLastError();
        if (cus < 256) { fprintf(stderr, "kernel_launch: built for a 256-CU device (one resident workgroup per CU), found %d CUs; nothing launched\n", cus); grid = -1; return; }
        grid = 256;
    }
    if (grid < 0) return;
    (void)hipMemsetAsync((char*)d_ws + WS_CTL, 0, CTL_ZERO_BYTES, stream);
    Args a{};
    for (int i = 0; i < N_IN; ++i) a.in[i] = (const float*)d_in[i];
    a.out = (float*)d_out; a.ws = (unsigned char*)d_ws;
#if MK_ONE_LAUNCH
    a.ph_lo = 0; a.ph_hi = N_PHASES;
    hipLaunchKernelGGL(fwd, dim3(grid), dim3(NTHREADS), LDS_BYTES, stream, a);
#else
    for (int p = 0; p < N_PHASES; ++p) { a.ph_lo = p; a.ph_hi = p + 1; hipLaunchKernelGGL(fwd, dim3(grid), dim3(NTHREADS), LDS_BYTES, stream, a); }
#endif
    const hipError_t le = hipPeekAtLastError();
    if (le != hipSuccess) fprintf(stderr, "kernel_launch: launch failed: %s\n", hipGetErrorName(le));
}
```

```cpp
#include <hip/hip_runtime.h>
#include <cstdio>

#ifndef MK_ONE_LAUNCH
#define MK_ONE_LAUNCH 1
#endif

#define GAS __attribute__((address_space(1)))
#define LAS __attribute__((address_space(3)))
typedef unsigned short bf16_t;
typedef short bf16x8 __attribute__((ext_vector_type(8)));
typedef float f32x4 __attribute__((ext_vector_type(4)));
typedef float f32x2 __attribute__((ext_vector_type(2)));
typedef float f32x16 __attribute__((ext_vector_type(16)));
typedef unsigned u32x4 __attribute__((ext_vector_type(4)));
typedef unsigned u32x2 __attribute__((ext_vector_type(2)));
typedef GAS unsigned gu32;
#define RLX_AGENT __ATOMIC_RELAXED, __HIP_MEMORY_SCOPE_AGENT
#define LDS_WAIT() asm volatile("s_waitcnt lgkmcnt(0)" ::: "memory")
#define VM_WAIT() asm volatile("s_waitcnt vmcnt(0)" ::: "memory")

constexpr int D = 2048, FF = 5632, NIN = 6144, DEPTH = 4;
constexpr int SEQ = 2048, NB = 4, DB = 128, DS = 8;
constexpr int MP = NB * SEQ, MS = DB * DS, M = MP + MS;
constexpr int SW = 1024, PW = 1024, NG = 64, NP = 64, NH = 16, PLE = 256, PBUF = 15;
constexpr float RMS_EPS = 1e-6f;
constexpr int NWAVES = 8, NTHREADS = 512;

enum { I_XP = 0, I_XS, I_SRE, I_SIM, I_SPOOL, I_PP, I_PS, I_GF1, I_WG1, I_WU1, I_WD1, I_GMIX, I_WIN, I_ARE, I_AIM, I_LDT, I_BRE, I_BIM, I_CRE, I_CIM, I_SD,
       I_GLA, I_GLB, I_WPOOL, I_PSCALE, I_WPU, I_WOUT, I_GF2, I_WG2, I_WU2, I_WD2, I_GPLE, I_WPLE, I_WPG, I_GFIN, N_IN };
constexpr size_t O_Y = 0, O_SRP = (size_t)M * D, O_SIP = O_SRP + 65536, O_PP = O_SIP + 65536, O_SRS = O_PP + 245760, O_SIS = O_SRS + 2097152, O_PS = O_SIS + 2097152,
                 O_END = O_PS + 7864320;

constexpr size_t MiB = 1u << 20;
constexpr size_t WS_CTL = 0, CTL_ZERO_BYTES = 14 * 16384;
constexpr size_t WO_GU1 = 0, WO_D1 = WO_GU1 + (size_t)2 * FF * D * 2, WO_IN = WO_D1 + (size_t)D * FF * 2, WO_GLU = WO_IN + (size_t)NIN * D * 2,
                 WO_PU = WO_GLU + (size_t)2 * D * SW * 2, WO_EFF = WO_PU + (size_t)D * PW * 2, WO_OUT = WO_EFF + (size_t)D * PW * 2, WO_GU2 = WO_OUT + (size_t)D * D * 2,
                 WO_D2 = WO_GU2 + (size_t)2 * FF * D * 2, WO_PG = WO_D2 + (size_t)D * FF * 2, WO_PLE = WO_PG + (size_t)D * D * 2, WO_POOL = WO_PLE + (size_t)D * PLE * 2,
                 WL = WO_POOL + (size_t)4 * 256 * 256 * 2;
constexpr size_t WS_W = 1 * MiB;
constexpr size_t WS_H = WS_W + DEPTH * WL;
constexpr size_t WS_HB0 = WS_H + (size_t)M * D * 4, WS_HB1 = WS_HB0 + (size_t)M * D * 2;
constexpr size_t WS_ACT = WS_HB1 + (size_t)M * D * 2;
constexpr size_t WS_UA = WS_ACT + (size_t)M * FF * 2, WS_UB = WS_UA + (size_t)M * SW * 2;
constexpr size_t WS_SGA = WS_UB + (size_t)M * PW * 2, WS_SGB = WS_SGA + (size_t)M * D * 2;
constexpr size_t WS_YA = WS_SGB + (size_t)M * D * 2, WS_MIX = WS_YA + (size_t)M * SW * 2;
constexpr size_t WS_PART = WS_MIX + (size_t)M * PW * 2, WS_MRG = WS_PART + (size_t)M * D * 2, WS_T1 = WS_MRG + (size_t)M * D * 2;
constexpr size_t WS_PB = WS_T1 + (size_t)M * D * 2;
constexpr size_t WS_SSQ = WS_PB + (size_t)DEPTH * M * PLE * 2;
constexpr size_t WS_END = WS_SSQ + (size_t)2 * M * 32 * 4;
static_assert(WL % 256 == 0 && WS_H % 256 == 0 && WS_SSQ % 256 == 0, "alignment");
constexpr int CW_BAR = 0;

constexpr int RING_BYTES = 131072, XS_OFF = RING_BYTES, XS_BYTES = 16384;
constexpr int LDSCTL_OFF = XS_OFF + XS_BYTES, MISC_OFF = LDSCTL_OFF + 320, LDS_BYTES = LDSCTL_OFF + 1024;

__device__ __forceinline__ int lane_id() { return (int)__builtin_amdgcn_mbcnt_hi(~0u, __builtin_amdgcn_mbcnt_lo(~0u, 0u)); }
#define TID_FROM(wv) ((wv) * 64 + lane_id())
typedef __bf16 bf16x2_t __attribute__((ext_vector_type(2)));
__device__ __forceinline__ unsigned cvt_pk_bf16(float lo, float hi) { const f32x2 v = {lo, hi}; return __builtin_bit_cast(unsigned, __builtin_convertvector(v, bf16x2_t)); }
__device__ __forceinline__ float bf_lo(unsigned w) { return __uint_as_float(w << 16); }
__device__ __forceinline__ float bf_hi(unsigned w) { return __uint_as_float(w & 0xffff0000u); }
__device__ __forceinline__ float sigmoid_f(float x) { return __builtin_amdgcn_rcpf(1.0f + __expf(-x)); }
__device__ __forceinline__ float wave_sum(float v) {
#pragma unroll
    for (int o = 1; o < 64; o <<= 1) v += __shfl_xor(v, o);
    return v;
}
struct SsqRegs { f32x4 a, b; };
__device__ __forceinline__ void ssq_load(const float* ssq, int row, int fq, SsqRegs& R) { const f32x4* p = (const f32x4*)(ssq + (size_t)row * 32 + 8 * fq); R.a = p[0]; R.b = p[1]; }
__device__ __forceinline__ float msq_from(const SsqRegs& R) {
    float s = ((R.a.x + R.a.y) + (R.a.z + R.a.w)) + ((R.b.x + R.b.y) + (R.b.z + R.b.w));
    s += __shfl_xor(s, 16); s += __shfl_xor(s, 32);
    return s * (1.0f / D) + RMS_EPS;
}
__device__ __forceinline__ f32x4 sigk4(const f32x4 t, const float kinv) {
    f32x4 e;
#pragma unroll
    for (int j = 0; j < 4; ++j) e[j] = __builtin_amdgcn_exp2f(t[j]);
    e = e * kinv + kinv;
#pragma unroll
    for (int j = 0; j < 4; ++j) e[j] = __builtin_amdgcn_rcpf(e[j]);
    return e;
}
__device__ __forceinline__ float rstd_from(const SsqRegs& R) {
    float s = ((R.a.x + R.a.y) + (R.a.z + R.a.w)) + ((R.b.x + R.b.y) + (R.b.z + R.b.w));
    s += __shfl_xor(s, 16); s += __shfl_xor(s, 32);
    return __builtin_amdgcn_rsqf(s * (1.0f / D) + RMS_EPS);
}

namespace pg8 {
constexpr int BM = 256, BK = 64, HALF = 128, HTB = HALF * BK * 2, STAGE_BYTES = 8 * HTB, NXCD = 8, WGM = 4;
__host__ __device__ __forceinline__ int lds_byte(int r, int c) { const int st = (r >> 4) * 2 + (c >> 5), rr = r & 15, cc = c & 31, ob = rr * 64 + cc * 2; return st * 1024 + (ob ^ (((ob >> 9) & 1) << 5)); }
__host__ __device__ __forceinline__ void stage_rc(int b, int& R, int& C) { const int st = b / 1024, sb = b % 1024, swz = sb ^ (((sb >> 9) & 1) << 5); R = (st >> 1) * 16 + swz / 64; C = (st & 1) * 32 + (swz % 64) / 2; }
__host__ __device__ __forceinline__ int perm32(int rho) { const int n = rho >> 4, i = rho & 15; return 8 * (i >> 2) + 4 * n + (i & 3); }

struct Unit { int pm, pn; unsigned aoff, boff, xoff; };
struct Gemm { const bf16_t* A; const bf16_t* Bt; int lda, ldb, K; const unsigned char* ws; };

struct StaticOrder {
    int nM, nN, nwg, G, c; unsigned ta, tb, tx, x0;
    __device__ void init(int Mrows, int N, int lda, int ldb, int G_, int c_) { nM = Mrows / BM; nN = N / BM; nwg = nM * nN; G = G_; c = c_; ta = (unsigned)BM * lda * 2u; tb = (unsigned)BM * ldb * 2u; tx = 32u * lda * 2u; x0 = (unsigned)MP * lda * 2u; }
    __device__ __forceinline__ bool next(int i, Unit& u) const {
        const long L = (long)i * G + c; if (L >= nwg) return false;
        int wgid = (int)L; { const int q = nwg / NXCD, r = nwg % NXCD, xcd = wgid % NXCD, off = wgid / NXCD; wgid = (xcd < r ? xcd * (q + 1) : r * (q + 1) + (xcd - r) * q) + off; }
        const int nig = WGM * nN, gid = wgid / nig, fm = gid * WGM, gsz = (nM - fm) < WGM ? (nM - fm) : WGM;
        u.pm = fm + ((wgid % nig) % gsz); u.pn = (wgid % nig) / gsz;
        u.aoff = (unsigned)u.pm * ta; u.boff = (unsigned)u.pn * tb; u.xoff = x0 + (unsigned)u.pm * tx; return true;
    }
};

struct NoExtra { __device__ __forceinline__ void after_unit(int, int, int) const {} };
struct NoPre { __device__ __forceinline__ void top() const {} __device__ __forceinline__ void rest() const {} };
template <class Epi, class Sched, bool XT, class Pre = NoPre, class Extra = NoExtra, bool ALIGN_EPI = true>
__device__ __forceinline__ void gemm_phase(LAS unsigned char* lds, const Gemm g, const Sched& S, const Epi& E, int wv, const Pre& P = Pre(), const Extra& X = Extra()) {
    asm volatile("" : "+s"(wv));
    int tid = TID_FROM(wv); asm volatile("" : "+v"(tid));
    const int wid = wv, lane = tid & 63, wr = wid >> 2, wc = wid & 3, fr = lane & 15, fq = lane >> 4;
    int K = g.K; asm volatile("" : "+s"(K));
    const int nt = K / BK;
    unsigned voffA, voffB;
    { int R, C; stage_rc(tid * 16, R, C); const int Rb = (R & ~31) + perm32(R & 31); voffA = (unsigned)(R * g.lda + C) * 2u; voffB = (unsigned)(Rb * g.ldb + C) * 2u; }
    const unsigned q_voffA = 64u * g.lda * 2u, q_voffB = 64u * g.ldb * 2u;
    const __amdgpu_buffer_rsrc_t rs = __builtin_amdgcn_make_buffer_rsrc((void*)g.ws, 0, (int)WS_END, 0x00020000);
    const unsigned oA = (unsigned)((const unsigned char*)g.A - g.ws), oB = (unsigned)((const unsigned char*)g.Bt - g.ws);
    const unsigned kstep = (unsigned)(BK * 2);
    const unsigned hstepA = (unsigned)HALF * g.lda * 2u, hstepB = (unsigned)HALF * g.ldb * 2u;
    const unsigned ldsw = (unsigned)wid * 1024u;
    const int aoff = lds_byte(wr * 64 + fr, fq * 8), boff = lds_byte(wc * 32 + fr, fq * 8);
    const int xadj = wr * (128 - 64 * g.lda); const unsigned xdst = XS_OFF + 8192u * ((wid >> 1) & 1) + 2048u * (wid >> 2) + 1024u * (wid & 1);
#define PG8_SA(b, h) (((b) * 2 + (h)) * HTB)
#define PG8_SB(b, h) ((4 + (b) * 2 + (h)) * HTB)
#define PG8_STAGE2(bufoff, gbase, voff, q) do { \
        __builtin_amdgcn_raw_ptr_buffer_load_lds(rs, (LAS unsigned*)(lds + (bufoff) + ldsw), 16, (int)(voff), (int)(gbase), 0, 0); \
        __builtin_amdgcn_raw_ptr_buffer_load_lds(rs, (LAS unsigned*)(lds + (bufoff) + ldsw + 8192), 16, (int)(voff), (int)((gbase) + (q)), 0, 0); } while (0)
#define PG8_STAGE(bufoff, gbase, voff) PG8_STAGE2(bufoff, gbase, voff, q_##voff)
#define PG8_STAGEX(slot, gbase) do { if constexpr (XT) __builtin_amdgcn_raw_ptr_buffer_load_lds(rs, (LAS unsigned*)(lds + xdst + (slot) * 4096), 16, (int)voffA, (int)(gbase) + xadj, 0, 0); } while (0)
#define PG8_LDA(dst, b, h) do { _Pragma("unroll") for (int m = 0; m < 4; ++m) _Pragma("unroll") for (int k = 0; k < 2; ++k) dst[m][k] = *(const LAS bf16x8*)(lds + PG8_SA(b, h) + aoff + m * 2048 + k * 1024); } while (0)
#define PG8_LDB(dst, b, h) do { _Pragma("unroll") for (int n = 0; n < 2; ++n) _Pragma("unroll") for (int k = 0; k < 2; ++k) dst[n][k] = *(const LAS bf16x8*)(lds + PG8_SB(b, h) + boff + n * 2048 + k * 1024); } while (0)
#define PG8_LDX(slot, kh) do { if constexpr (XT) { _Pragma("unroll") for (int k = 0; k < 2; ++k) Xf[k] = *(const LAS bf16x8*)(lds + XS_OFF + aoff + (slot) * 4096 + (kh) * 2048 + k * 1024); } } while (0)
#define PG8_MMA(ai, bj, At, Bt) do { _Pragma("unroll") for (int m = 0; m < 4; ++m) _Pragma("unroll") for (int n = 0; n < 2; ++n) _Pragma("unroll") for (int k = 0; k < 2; ++k) \
        acc[ai][bj][m][n] = __builtin_amdgcn_mfma_f32_16x16x32_bf16(Bt[n][k], At[m][k], acc[ai][bj][m][n], 0, 0, 0); } while (0)
#define PG8_MMAX() do { if constexpr (XT) { _Pragma("unroll") for (int n = 0; n < 2; ++n) _Pragma("unroll") for (int k = 0; k < 2; ++k) { \
        accx[0][n] = __builtin_amdgcn_mfma_f32_16x16x32_bf16(B0[n][k], Xf[k], accx[0][n], 0, 0, 0); accx[1][n] = __builtin_amdgcn_mfma_f32_16x16x32_bf16(B1[n][k], Xf[k], accx[1][n], 0, 0, 0); } } } while (0)
#define PG8_WAIT_V(n) asm volatile("s_waitcnt vmcnt(" #n ")" ::: "memory")
#define PG8_WAIT_VX(nx, n) do { if constexpr (XT) PG8_WAIT_V(nx); else PG8_WAIT_V(n); } while (0)
#define PG8_WAIT_L(n) asm volatile("s_waitcnt lgkmcnt(" #n ")" ::: "memory")
#define PG8_BAR __builtin_amdgcn_s_barrier()
#define PG8_SCHED __builtin_amdgcn_sched_barrier(0)
#define PG8_PRIO(p) __builtin_amdgcn_s_setprio(p)
    Unit cur, nxt; int ui = 0;
    if (!S.next(0, cur)) { P.top(); P.rest(); return; }
    f32x4 acc[2][2][4][2], accx[2][2];
#pragma unroll
    for (int a = 0; a < 2; ++a)
#pragma unroll
        for (int b = 0; b < 2; ++b) {
#pragma unroll
            for (int m = 0; m < 4; ++m)
#pragma unroll
                for (int n = 0; n < 2; ++n) acc[a][b][m][n] = (f32x4){0.f, 0.f, 0.f, 0.f};
            accx[a][b] = (f32x4){0.f, 0.f, 0.f, 0.f}; }
    bf16x8 At[4][2], B0[2][2], B1[2][2], Xf[2];
    unsigned cA = oA + cur.aoff, cB = oB + cur.boff, cX = oA + cur.xoff;
    int xs = 0;
    P.top();
    PG8_STAGE(PG8_SB(0, 0), cB, voffB); PG8_STAGE(PG8_SB(0, 1), cB + hstepB, voffB);
    P.rest();
    PG8_STAGEX(0, cX);
    PG8_STAGE(PG8_SA(0, 0), cA, voffA); PG8_STAGE(PG8_SA(0, 1), cA + hstepA, voffA);
    if (wr == 1) PG8_BAR;
    PG8_WAIT_V(2); PG8_BAR;
    PG8_STAGE(PG8_SB(1, 0), cB + kstep, voffB); PG8_STAGE(PG8_SA(1, 0), cA + kstep, voffA); PG8_STAGE(PG8_SB(1, 1), cB + hstepB + kstep, voffB);
    PG8_WAIT_V(6); PG8_BAR;
    for (;;) {
        const bool has_next = S.next(ui + 1, nxt);
        const unsigned nA = has_next ? oA + nxt.aoff : cA, nB = has_next ? oB + nxt.boff : cB, nX = has_next ? oA + nxt.xoff : cX;
        for (int t = 0; t < nt; t += 2) {
            const bool last = (t == nt - 2);
            const unsigned a1 = cA + (unsigned)(t + 1) * kstep;
            const unsigned a2 = last ? nA : cA + (unsigned)(t + 2) * kstep, b2 = last ? nB : cB + (unsigned)(t + 2) * kstep, x2 = last ? nX : cX + (unsigned)(t + 2) * kstep;
            const unsigned a3 = a2 + kstep, b3 = b2 + kstep;
            PG8_LDB(B0, 0, 0); PG8_LDB(B1, 0, 1); PG8_SCHED; PG8_LDA(At, 0, 0); PG8_LDX(xs, 0); PG8_STAGEX(xs ^ 1, x2); PG8_STAGE(PG8_SA(1, 1), a1 + hstepA, voffA);
            PG8_WAIT_VX(9, 8); PG8_WAIT_L(0); PG8_BAR; PG8_PRIO(1); PG8_MMA(0, 0, At, B0); PG8_MMA(0, 1, At, B1); PG8_MMAX(); PG8_PRIO(0); PG8_BAR; PG8_SCHED;
            PG8_LDA(At, 0, 1); PG8_STAGE(PG8_SB(0, 0), b2, voffB); PG8_STAGE(PG8_SB(0, 1), b2 + hstepB, voffB); PG8_STAGE(PG8_SA(0, 0), a2, voffA);
            PG8_WAIT_VX(9, 8); PG8_WAIT_L(0); PG8_BAR; PG8_PRIO(1); PG8_MMA(1, 0, At, B0); PG8_MMA(1, 1, At, B1); PG8_PRIO(0); PG8_BAR; PG8_SCHED;
            PG8_LDB(B0, 1, 0); PG8_LDB(B1, 1, 1); PG8_SCHED; PG8_LDA(At, 1, 0); PG8_LDX(xs, 1); PG8_STAGE(PG8_SA(0, 1), a2 + hstepA, voffA);
            PG8_WAIT_V(8); PG8_WAIT_L(0); PG8_BAR; PG8_PRIO(1); PG8_MMA(0, 0, At, B0); PG8_MMA(0, 1, At, B1); PG8_MMAX(); PG8_PRIO(0); PG8_BAR; PG8_SCHED;
            PG8_LDA(At, 1, 1); PG8_STAGE(PG8_SB(1, 0), b3, voffB); PG8_STAGE(PG8_SB(1, 1), b3 + hstepB, voffB); PG8_STAGE(PG8_SA(1, 0), a3, voffA);
            PG8_WAIT_V(8); PG8_WAIT_L(0); PG8_BAR; PG8_PRIO(1); PG8_MMA(1, 0, At, B0); PG8_MMA(1, 1, At, B1); PG8_PRIO(0); PG8_BAR; PG8_SCHED;
            xs ^= 1;
        }
        if constexpr (ALIGN_EPI) { if (wr == 0) PG8_BAR; }
        {
            asm volatile("s_nop 15\n\ts_nop 15\n\ts_nop 15\n\ts_nop 15" ::: "memory");
            int lz = lane_id(); asm volatile("" : "+v"(lz)); const int fr2 = lz & 15, fq2 = lz >> 4;
            constexpr int NR = XT ? 9 : 8, BT = Epi::BATCH;
#pragma unroll
            for (int r0 = 0; r0 < NR; r0 += BT) {
                typename Epi::Regs R[BT];
#pragma unroll
                for (int b = 0; b < BT; ++b) if (r0 + b < NR) { const int r = r0 + b; E.load(r < 8 ? cur.pm * BM + (r >> 2) * HALF + wr * 64 + (r & 3) * 16 + fr2 : MP + 32 * cur.pm + wr * 16 + fr2, cur, wc, fq2, R[b]); }
                if (Epi::HAS_LOADS) asm volatile("s_waitcnt vmcnt(0)" ::: "memory");
#pragma unroll
                for (int b = 0; b < BT; ++b) if (r0 + b < NR) { const int r = r0 + b; const int row = r < 8 ? cur.pm * BM + (r >> 2) * HALF + wr * 64 + (r & 3) * 16 + fr2 : MP + 32 * cur.pm + wr * 16 + fr2;
                    if (r < 8) E.fin(acc[r >> 2][0][r & 3][0], acc[r >> 2][0][r & 3][1], acc[r >> 2][1][r & 3][0], acc[r >> 2][1][r & 3][1], row, cur, wc, fq2, R[b]);
                    else E.fin(accx[0][0], accx[0][1], accx[1][0], accx[1][1], row, cur, wc, fq2, R[b]); }
            }
        }
        X.after_unit(ui, wid, lane_id());
        if (!has_next) break;
#pragma unroll
        for (int a = 0; a < 2; ++a)
#pragma unroll
            for (int b = 0; b < 2; ++b) {
#pragma unroll
                for (int m = 0; m < 4; ++m)
#pragma unroll
                    for (int n = 0; n < 2; ++n) acc[a][b][m][n] = (f32x4){0.f, 0.f, 0.f, 0.f};
                accx[a][b] = (f32x4){0.f, 0.f, 0.f, 0.f}; }
        cur = nxt; cA = nA; cB = nB; cX = nX; ++ui;
        if constexpr (ALIGN_EPI) { if (wr == 1) PG8_BAR; }
    }
    PG8_WAIT_V(0);
    if constexpr (!ALIGN_EPI) { if (wr == 0) PG8_BAR; }
    PG8_BAR;
#undef PG8_SA
#undef PG8_SB
#undef PG8_STAGE
#undef PG8_STAGE2
#undef PG8_STAGEX
#undef PG8_LDA
#undef PG8_LDB
#undef PG8_LDX
#undef PG8_MMA
#undef PG8_MMAX
#undef PG8_WAIT_V
#undef PG8_WAIT_VX
#undef PG8_WAIT_L
#undef PG8_BAR
#undef PG8_SCHED
#undef PG8_PRIO
}
}

__device__ __forceinline__ u32x4 pack8(const f32x4 a, const f32x4 b) { u32x4 w; w.x = cvt_pk_bf16(a[0], a[1]); w.y = cvt_pk_bf16(a[2], a[3]); w.z = cvt_pk_bf16(b[0], b[1]); w.w = cvt_pk_bf16(b[2], b[3]); return w; }
__device__ __forceinline__ void unpack8(const u32x4 w, f32x4& a, f32x4& b) { a = (f32x4){bf_lo(w.x), bf_hi(w.x), bf_lo(w.y), bf_hi(w.y)}; b = (f32x4){bf_lo(w.z), bf_hi(w.z), bf_lo(w.w), bf_hi(w.w)}; }
__device__ __forceinline__ float sumsq8(const f32x4 a, const f32x4 b) { return ((a[0] * a[0] + a[1] * a[1]) + (a[2] * a[2] + a[3] * a[3])) + ((b[0] * b[0] + b[1] * b[1]) + (b[2] * b[2] + b[3] * b[3])); }

struct EpiGateUp {
    bf16_t* act; const float* ssq;
    typedef SsqRegs Regs; static constexpr int BATCH = 5; static constexpr bool HAS_LOADS = true;
    __device__ __forceinline__ void load(int row, const pg8::Unit&, int, int fq, Regs& R) const { ssq_load(ssq, row, fq, R); }
    __device__ __forceinline__ void fin(const f32x4 g0, const f32x4 g1, const f32x4 u0, const f32x4 u1, int row, const pg8::Unit& u, int wc, int fq, const Regs& R) const {
        const float m = msq_from(R), c = __builtin_amdgcn_rsqf(m) * -1.4426950408889634f;
        *(u32x4*)(act + (size_t)row * FF + u.pn * 128 + wc * 32 + 8 * fq) = pack8((g0 * u0) * sigk4(g0 * c, m), (g1 * u1) * sigk4(g1 * c, m));
    }
};
struct EpiResid {
    float* h; bf16_t* hb; float* ssq_out; float scale; const float* src_p; const float* src_s;
    struct Regs { f32x4 h0, h1, h2, h3; }; static constexpr int BATCH = 3; static constexpr bool HAS_LOADS = true;
    __device__ __forceinline__ void load(int row, const pg8::Unit& u, int wc, int fq, Regs& R) const {
        const float* hp = (row < MP ? src_p + (size_t)row * D : src_s + (size_t)(row - MP) * D) + u.pn * 256 + wc * 32 + 8 * fq; R.h0 = *(const f32x4*)hp; R.h1 = *(const f32x4*)(hp + 4); R.h2 = *(const f32x4*)(hp + 128); R.h3 = *(const f32x4*)(hp + 132); }
    __device__ __forceinline__ void fin(const f32x4 a0, const f32x4 a1, const f32x4 b0, const f32x4 b1, int row, const pg8::Unit& u, int wc, int fq, const Regs& R) const {
        const size_t o = (size_t)row * D + u.pn * 256 + wc * 32 + 8 * fq; float* hp = h + o;
        const f32x4 v0 = R.h0 + a0 * scale, v1 = R.h1 + a1 * scale, w0 = R.h2 + b0 * scale, w1 = R.h3 + b1 * scale;
        *(f32x4*)hp = v0; *(f32x4*)(hp + 4) = v1; *(f32x4*)(hp + 128) = w0; *(f32x4*)(hp + 132) = w1;
        *(u32x4*)(hb + o) = pack8(v0, v1); *(u32x4*)(hb + o + 128) = pack8(w0, w1);
        float ss = sumsq8(v0, v1) + sumsq8(w0, w1); ss += __shfl_xor(ss, 16); ss += __shfl_xor(ss, 32);
        if (fq == 0) ssq_out[(size_t)row * 32 + u.pn * 4 + wc] = ss;
    }
};
struct EpiWin {
    bf16_t *ua, *ub, *sga, *sgb; const float* ssq;
    typedef SsqRegs Regs; static constexpr int BATCH = 5; static constexpr bool HAS_LOADS = true;
    __device__ __forceinline__ void load(int row, const pg8::Unit&, int, int fq, Regs& R) const { ssq_load(ssq, row, fq, R); }
    __device__ __forceinline__ void fin(const f32x4 a0, const f32x4 a1, const f32x4 b0, const f32x4 b1, int row, const pg8::Unit& u, int wc, int fq, const Regs& R) const {
        int colt = u.pn * 256; bf16_t* base; int ld; bool sg;
        if (u.pn < 4) { base = ua; ld = SW; sg = false; } else if (u.pn < 8) { base = ub; ld = PW; sg = false; colt -= 1024; }
        else if (u.pn < 16) { base = sga; ld = D; sg = true; colt -= 2048; } else { base = sgb; ld = D; sg = true; colt -= 4096; }
        const float rs = rstd_from(R); f32x4 v0, v1, w0, w1;
        if (sg) { const float c = rs * -1.4426950408889634f; v0 = sigk4(a0 * c, 1.0f); v1 = sigk4(a1 * c, 1.0f); w0 = sigk4(b0 * c, 1.0f); w1 = sigk4(b1 * c, 1.0f); }
        else { v0 = a0 * rs; v1 = a1 * rs; w0 = b0 * rs; w1 = b1 * rs; }
        bf16_t* p = base + (size_t)row * ld + colt + wc * 32 + 8 * fq;
        *(u32x4*)p = pack8(v0, v1); *(u32x4*)(p + 128) = pack8(w0, w1);
    }
};
struct EpiGlu {
    const bf16_t* sga; bf16_t* part;
    struct Regs { u32x4 s; }; static constexpr int BATCH = 9; static constexpr bool HAS_LOADS = true;
    __device__ __forceinline__ void load(int row, const pg8::Unit& u, int wc, int fq, Regs& R) const { R.s = *(const u32x4*)(sga + (size_t)row * D + u.pn * 128 + wc * 32 + 8 * fq); }
    __device__ __forceinline__ void fin(const f32x4 a0, const f32x4 a1, const f32x4 b0, const f32x4 b1, int row, const pg8::Unit& u, int wc, int fq, const Regs& R) const {
        const size_t o = (size_t)row * D + u.pn * 128 + wc * 32 + 8 * fq;
        f32x4 s0, s1; unpack8(R.s, s0, s1);
        *(u32x4*)(part + o) = pack8((s0 * a0) * sigk4(b0 * -1.4426950408889634f, 1.0f), (s1 * a1) * sigk4(b1 * -1.4426950408889634f, 1.0f));
    }
};
struct EpiPoolUp {
    const bf16_t* sgb; const bf16_t* part; bf16_t* mrg;
    struct Regs { u32x4 s0, p0, s1, p1; }; static constexpr int BATCH = 3; static constexpr bool HAS_LOADS = true;
    __device__ __forceinline__ void load(int row, const pg8::Unit& u, int wc, int fq, Regs& R) const {
        const size_t o = (size_t)row * D + u.pn * 256 + wc * 32 + 8 * fq; R.s0 = *(const u32x4*)(sgb + o); R.p0 = *(const u32x4*)(part + o); R.s1 = *(const u32x4*)(sgb + o + 128); R.p1 = *(const u32x4*)(part + o + 128); }
    __device__ __forceinline__ void fin(const f32x4 a0, const f32x4 a1, const f32x4 b0, const f32x4 b1, int row, const pg8::Unit& u, int wc, int fq, const Regs& R) const {
        const size_t o = (size_t)row * D + u.pn * 256 + wc * 32 + 8 * fq;
        f32x4 s0, s1, p0, p1, t0, t1, q0, q1; unpack8(R.s0, s0, s1); unpack8(R.p0, p0, p1); unpack8(R.s1, t0, t1); unpack8(R.p1, q0, q1);
        *(u32x4*)(mrg + o) = pack8(p0 + s0 * a0, p1 + s1 * a1); *(u32x4*)(mrg + o + 128) = pack8(q0 + t0 * b0, q1 + t1 * b1);
    }
};
struct EpiStore {
    bf16_t* out; int ldc;
    struct Regs {}; static constexpr int BATCH = 1; static constexpr bool HAS_LOADS = false;
    __device__ __forceinline__ void load(int, const pg8::Unit&, int, int, Regs&) const {}
    __device__ __forceinline__ void fin(const f32x4 a0, const f32x4 a1, const f32x4 b0, const f32x4 b1, int row, const pg8::Unit& u, int wc, int fq, const Regs&) const {
        bf16_t* p = out + (size_t)row * ldc + u.pn * 256 + wc * 32 + 8 * fq; *(u32x4*)p = pack8(a0, a1); *(u32x4*)(p + 128) = pack8(b0, b1);
    }
};
struct EpiPle {
    float* h; const bf16_t* t1; bf16_t* hb; const float* ssq; float* ssq_out;
    struct Regs { SsqRegs q; f32x4 h0, h1, h2, h3; u32x4 ta, tb; }; static constexpr int BATCH = 2; static constexpr bool HAS_LOADS = true;
    __device__ __forceinline__ void load(int row, const pg8::Unit& u, int wc, int fq, Regs& R) const {
        ssq_load(ssq, row, fq, R.q); const size_t o = (size_t)row * D + u.pn * 256 + wc * 32 + 8 * fq; const float* hp = h + o;
        R.h0 = *(const f32x4*)hp; R.h1 = *(const f32x4*)(hp + 4); R.h2 = *(const f32x4*)(hp + 128); R.h3 = *(const f32x4*)(hp + 132); R.ta = *(const u32x4*)(t1 + o); R.tb = *(const u32x4*)(t1 + o + 128); }
    __device__ __forceinline__ void fin(const f32x4 a0, const f32x4 a1, const f32x4 b0, const f32x4 b1, int row, const pg8::Unit& u, int wc, int fq, const Regs& R) const {
        const float rs = rstd_from(R.q);
        const size_t o = (size_t)row * D + u.pn * 256 + wc * 32 + 8 * fq; float* hp = h + o;
        f32x4 t0, t1v, t2, t3; unpack8(R.ta, t0, t1v); unpack8(R.tb, t2, t3);
        f32x4 v0 = R.h0, v1 = R.h1, w0 = R.h2, w1 = R.h3;
        { const float c = rs * -1.4426950408889634f; v0 += t0 * sigk4(a0 * c, 1.0f); v1 += t1v * sigk4(a1 * c, 1.0f); w0 += t2 * sigk4(b0 * c, 1.0f); w1 += t3 * sigk4(b1 * c, 1.0f); }
        *(f32x4*)hp = v0; *(f32x4*)(hp + 4) = v1; *(f32x4*)(hp + 128) = w0; *(f32x4*)(hp + 132) = w1;
        if (hb) { *(u32x4*)(hb + o) = pack8(v0, v1); *(u32x4*)(hb + o + 128) = pack8(w0, w1); }
        float ss = sumsq8(v0, v1) + sumsq8(w0, w1); ss += __shfl_xor(ss, 16); ss += __shfl_xor(ss, 32);
        if (fq == 0) ssq_out[(size_t)row * 32 + u.pn * 4 + wc] = ss;
    }
};
struct WeffOrder {
    int c;
    __device__ __forceinline__ bool next(int i, pg8::Unit& u) const {
        if (i != 0 || c < 0 || c >= 32) return false;
        const int gi = c >> 3; u.pm = c & 7; u.pn = gi; u.xoff = 0;
        u.aoff = (unsigned)(gi * 512 + (size_t)u.pm * 256 * PW * 2); u.boff = (unsigned)(gi * 131072); return true;
    }
};
struct GluOrder {
    pg8::StaticOrder base;
    __device__ __forceinline__ bool next(int i, pg8::Unit& u) const {
        if (!base.next(i >> 1, u)) return false;
        u.pn = 2 * u.pn + (i & 1); u.boff = (unsigned)u.pn * base.tb; return true;
    }
};
struct EpiWeff {
    bf16_t* weff;
    struct Regs {}; static constexpr int BATCH = 1; static constexpr bool HAS_LOADS = false;
    __device__ __forceinline__ void load(int, const pg8::Unit&, int, int, Regs&) const {}
    __device__ __forceinline__ void fin(const f32x4 a0, const f32x4 a1, const f32x4 b0, const f32x4 b1, int row, const pg8::Unit& u, int wc, int fq, const Regs&) const {
        bf16_t* p = weff + (size_t)row * PW + u.pn * 256 + wc * 32 + 8 * fq;
        *(u32x4*)p = pack8(a0, a1); *(u32x4*)(p + 128) = pack8(b0, b1);
    }
};

#define XB_TMO      128
#define XB_XCNT(j)  (256  + 64 * (j))
#define XB_XSUB(j)  (1280 + 64 * (j))
#define XB_XGEN(j)  (2304 + 64 * (j))
#define XB_TOP      3328
#define XB_TOPGEN   3392
#define XCD_BAR_WORDS 3456
#define XB_SPIN_CAP (1u << 22)
__device__ __forceinline__ unsigned xb_ld(unsigned* p)              { return __hip_atomic_load(p, __ATOMIC_RELAXED, __HIP_MEMORY_SCOPE_AGENT); }
__device__ __forceinline__ unsigned xb_add(unsigned* p, unsigned v) { return __hip_atomic_fetch_add(p, v, __ATOMIC_RELAXED, __HIP_MEMORY_SCOPE_AGENT); }
__device__ __forceinline__ unsigned xb_xcc_id() { return (unsigned)__builtin_amdgcn_s_getreg((3 << 11) | 20) & 0xFu; }
#define XB_SPIN(cond, bar) do { unsigned _sp = 0; while (cond) { __builtin_amdgcn_s_sleep(1); \
    if ((++_sp & 255u) == 0u) { if (xb_ld(&(bar)[XB_TMO])) break; if (_sp > XB_SPIN_CAP) { atomicAdd(&(bar)[XB_TMO], 1u); break; } } } } while (0)
struct XcdBarrier { unsigned* bar; unsigned x; volatile LAS unsigned* st; unsigned G; };
__device__ __forceinline__ XcdBarrier xcd_barrier_post(unsigned* bar, volatile LAS unsigned* st, bool t0, unsigned G) {
    XcdBarrier b; b.bar = bar; b.x = xb_xcc_id(); b.st = st; b.G = G;
    if (t0) (void)xb_add(&bar[XB_XCNT(b.x)], 1u);
    return b;
}
__device__ __forceinline__ void xcd_barrier_complete(unsigned* bar, unsigned x, unsigned& nloc, unsigned& nx, unsigned G) {
    unsigned sum, cnt, mine, sp = 0u;
    for (;;) {
        sum = 0u; cnt = 0u; mine = 0u;
#pragma unroll
        for (unsigned j = 0; j < 16; ++j) { const unsigned c = xb_ld(&bar[XB_XCNT(j)]); sum += c; cnt += (c > 0u) ? 1u : 0u; mine = (j == x) ? c : mine; }
        if (sum == G) break;
        __builtin_amdgcn_s_sleep(1);
        if ((++sp & 255u) == 0u) { if (xb_ld(&bar[XB_TMO])) break; if (sp > XB_SPIN_CAP) { atomicAdd(&bar[XB_TMO], 1u); break; } }
    }
    nloc = mine > 0u ? mine : 1u; nx = cnt > 0u ? cnt : 1u;
}
__device__ __forceinline__ void xcd_barrier_top() { asm volatile("s_waitcnt vmcnt(0)" ::: "memory"); __syncthreads(); }
__device__ __forceinline__ void xcd_barrier_rest(const XcdBarrier& b, bool t0) {
    if (t0) {
        unsigned* bar = b.bar;
        asm volatile("s_waitcnt lgkmcnt(0)" ::: "memory");
        unsigned nloc = b.st[0], nx = b.st[1];
        if (nloc == 0u) { xcd_barrier_complete(bar, b.x, nloc, nx, b.G); b.st[0] = nloc; b.st[1] = nx; }
        const unsigned old = xb_add(&bar[XB_XSUB(b.x)], 1u);
        const unsigned gen = old / nloc;
        if (nx == 1u) {
            __builtin_amdgcn_fence(__ATOMIC_ACQUIRE, "agent");
            XB_SPIN(xb_ld(&bar[XB_XSUB(b.x)]) < (gen + 1u) * nloc, bar);
            asm volatile("s_waitcnt vmcnt(0)" ::: "memory");
        } else if (old + 1u == (gen + 1u) * nloc) {
            __builtin_amdgcn_fence(__ATOMIC_RELEASE, "agent");
            asm volatile("s_waitcnt vmcnt(0)" ::: "memory");
            const unsigned og = xb_add(&bar[XB_TOP], 1u);
            const unsigned tg = og / nx;
            if (og + 1u == (tg + 1u) * nx) xb_add(&bar[XB_TOPGEN], 1u);
            else XB_SPIN(xb_ld(&bar[XB_TOPGEN]) == tg, bar);
            __builtin_amdgcn_fence(__ATOMIC_ACQUIRE, "agent");
            xb_add(&bar[XB_XGEN(b.x)], 1u);
            asm volatile("s_waitcnt vmcnt(0)" ::: "memory");
        } else {
            XB_SPIN(xb_ld(&bar[XB_XGEN(b.x)]) == gen, bar);
            __builtin_amdgcn_fence(__ATOMIC_ACQUIRE, "agent");
            asm volatile("s_waitcnt vmcnt(0)" ::: "memory");
        }
    }
    __syncthreads();
}
__device__ __forceinline__ void xcd_barrier(const XcdBarrier& b, bool t0) { xcd_barrier_top(); xcd_barrier_rest(b, t0); }
struct BarPre { const XcdBarrier& b; bool on, t0;
    __device__ __forceinline__ void top() const { if (on) xcd_barrier_top(); }
    __device__ __forceinline__ void rest() const { if (on) xcd_barrier_rest(b, t0); } };

__device__ __forceinline__ void evt_arrive(unsigned* w, bool t0) {
    asm volatile("s_waitcnt vmcnt(0)" ::: "memory"); __syncthreads();
    if (t0) { __builtin_amdgcn_fence(__ATOMIC_RELEASE, "agent"); asm volatile("s_waitcnt vmcnt(0)" ::: "memory"); (void)xb_add(w, 1u); }
}
__device__ __forceinline__ void evt_arrive_wt(unsigned* w, bool t0) {
    asm volatile("s_waitcnt vmcnt(0)" ::: "memory"); __syncthreads();
    if (t0) (void)xb_add(w, 1u);
}
__device__ __forceinline__ void evt_poll(unsigned* w, unsigned target, unsigned* tmo, bool t0) {
    if (t0) { unsigned sp = 0u;
        while (xb_ld(w) < target) { __builtin_amdgcn_s_sleep(1); if ((++sp & 255u) == 0u) { if (xb_ld(tmo)) break; if (sp > XB_SPIN_CAP) { atomicAdd(tmo, 1u); break; } } } }
}
__device__ __forceinline__ void evt_wait(unsigned* w, unsigned target, unsigned* tmo, bool t0) {
    if (t0) { unsigned sp = 0u;
        while (xb_ld(w) < target) { __builtin_amdgcn_s_sleep(1); if ((++sp & 255u) == 0u) { if (xb_ld(tmo)) break; if (sp > XB_SPIN_CAP) { atomicAdd(tmo, 1u); break; } } }
        __builtin_amdgcn_fence(__ATOMIC_ACQUIRE, "agent"); asm volatile("s_waitcnt vmcnt(0)" ::: "memory"); }
    __syncthreads();
}

struct Args { const float* in[N_IN]; float* out; unsigned char* ws; int ph_lo, ph_hi; };
static_assert(sizeof(Args) == (N_IN + 2) * 8 + 8, "Args has no padding");
typedef const __attribute__((address_space(4))) Args* CArgs;
__device__ __forceinline__ CArgs args_ptr() { CArgs p = (CArgs)__builtin_amdgcn_kernarg_segment_ptr(); asm volatile("" : "+s"(p)); return p; }

constexpr int CT_PITCH = 144;
struct ConvJob { const float* W; bf16_t* WT; const float* gain; int K, N, mode; };
__device__ __forceinline__ void conv_load(const ConvJob& J, int item, int lane, f32x4 (&v)[16], int& k0, int& n0) {
    const int nblk = J.N / 64, kb = item / nblk, nb = item % nblk; k0 = 64 * kb; n0 = 64 * nb;
    const float* src = J.W + (size_t)(k0 + 16 * (lane >> 4)) * J.N + n0 + 4 * (lane & 15);
#pragma unroll
    for (int i = 0; i < 16; ++i) v[i] = *(const f32x4*)(src + (size_t)i * J.N);
    if (J.gain) { const f32x4* gp = (const f32x4*)(J.gain + k0 + 16 * (lane >> 4));
#pragma unroll
        for (int i4 = 0; i4 < 4; ++i4) { const f32x4 gq = gp[i4];
#pragma unroll
            for (int e = 0; e < 4; ++e) v[4 * i4 + e] *= gq[e]; } }
}
__device__ __forceinline__ void conv_store(const ConvJob& J, int k0, int n0, int lane, const f32x4 (&v)[16], LAS unsigned char* img) {
#pragma unroll
    for (int j = 0; j < 4; ++j) { LAS unsigned char* p = img + (4 * (lane & 15) + j) * CT_PITCH + 32 * (lane >> 4);
        u32x4 lo, hi; lo.x = cvt_pk_bf16(v[0][j], v[1][j]); lo.y = cvt_pk_bf16(v[2][j], v[3][j]); lo.z = cvt_pk_bf16(v[4][j], v[5][j]); lo.w = cvt_pk_bf16(v[6][j], v[7][j]);
        hi.x = cvt_pk_bf16(v[8][j], v[9][j]); hi.y = cvt_pk_bf16(v[10][j], v[11][j]); hi.z = cvt_pk_bf16(v[12][j], v[13][j]); hi.w = cvt_pk_bf16(v[14][j], v[15][j]);
        *(LAS u32x4*)p = lo; *(LAS u32x4*)(p + 16) = hi; }
    LDS_WAIT(); asm volatile("" ::: "memory");
#pragma unroll
    for (int jj = 0; jj < 8; ++jj) { const int n = (lane >> 3) + 8 * jj, ng = n0 + n; const int r = J.mode == 0 ? ng : (256 * (ng >> 7) + (J.mode == 2 ? 128 : 0) + (ng & 127));
        const u32x4 o = *(const LAS u32x4*)(img + n * CT_PITCH + 16 * (lane & 7));
        { bf16_t* gp = J.WT + (size_t)r * J.K + k0 + 8 * (lane & 7); asm volatile("global_store_dwordx4 %0, %1, off sc1\n\ts_nop 1" :: "v"(gp), "v"(o) : "memory"); } }
    LDS_WAIT(); asm volatile("" ::: "memory");
}
constexpr int CI_FF = (D / 64) * (FF / 64), CI_DN = (FF / 64) * (D / 64), CI_IN = (D / 64) * (NIN / 64), CI_GL = (SW / 64) * (D / 64), CI_DD = (D / 64) * (D / 64), CI_PL = (PLE / 64) * (D / 64);
constexpr int CI_LAYER = 4 * CI_FF + 2 * CI_DN + CI_IN + 3 * CI_GL + 2 * CI_DD + CI_PL;

__device__ __forceinline__ ConvJob conv_job(CArgs a, unsigned char* ws, int l, int& r) {
    unsigned char* wl = ws + WS_W + (size_t)l * WL; ConvJob J;
#define CJ(cnt, idx, Kk, Nn, dst, md, gidx, gK) if (r < (cnt)) { J.W = a->in[idx] + (size_t)l * (Kk) * (Nn); J.WT = (bf16_t*)(wl + (dst)); J.gain = (gidx) >= 0 ? a->in[(gidx) >= 0 ? (gidx) : 0] + (size_t)l * (gK) : nullptr; J.K = Kk; J.N = Nn; J.mode = md; return J; } r -= (cnt);
    CJ(CI_GL, I_WPU, PW, D, WO_PU, 0, I_PSCALE, PW)
    CJ(CI_FF, I_WG1, D, FF, WO_GU1, 1, I_GF1, D)
    CJ(CI_FF, I_WU1, D, FF, WO_GU1, 2, I_GF1, D)
    CJ(CI_DN, I_WD1, FF, D, WO_D1, 0, -1, 0)
    CJ(CI_IN, I_WIN, D, NIN, WO_IN, 0, I_GMIX, D)
    CJ(CI_GL, I_GLA, SW, D, WO_GLU, 1, -1, 0)
    CJ(CI_GL, I_GLB, SW, D, WO_GLU, 2, -1, 0)
    CJ(CI_DD, I_WOUT, D, D, WO_OUT, 0, -1, 0)
    CJ(CI_FF, I_WG2, D, FF, WO_GU2, 1, I_GF2, D)
    CJ(CI_FF, I_WU2, D, FF, WO_GU2, 2, I_GF2, D)
    CJ(CI_DN, I_WD2, FF, D, WO_D2, 0, -1, 0)
    CJ(CI_DD, I_WPG, D, D, WO_PG, 0, I_GPLE, D)
#undef CJ
    J.W = a->in[I_WPLE] + (size_t)l * PLE * D; J.WT = (bf16_t*)(wl + WO_PLE); J.gain = nullptr; J.K = PLE; J.N = D; J.mode = 0; return J;
}
__device__ __forceinline__ void conv_range(CArgs a, unsigned char* ws, int l, int lo, int hi, int idx, int stride, int lane, LAS unsigned char* img) {
    for (int it = lo + idx; it < hi; it += 2 * stride) {
        const int it2 = it + stride; const bool two = it2 < hi;
        int r1 = it, r2 = two ? it2 : it; const ConvJob J1 = conv_job(a, ws, l, r1), J2 = conv_job(a, ws, l, r2);
        f32x4 v1[16], v2[16]; int k1, n1, k2, n2;
        conv_load(J1, r1, lane, v1, k1, n1); conv_load(J2, r2, lane, v2, k2, n2);
        conv_store(J1, k1, n1, lane, v1, img);
        if (two) conv_store(J2, k2, n2, lane, v2, img);
    }
}
constexpr int CI_SPLIT = CI_GL + 2 * CI_FF + CI_DN + CI_IN;
__device__ __forceinline__ void deferred_convert(int layer, int part, int c128, int wv, LAS unsigned char* lds) {
    if (layer >= DEPTH) return;
    int wave = wv; asm volatile("" : "+s"(wave)); const int lane = lane_id();
    CArgs a = args_ptr(); unsigned char* ws = a->ws;
    const int lo = part ? CI_SPLIT : 0, hi = part ? CI_LAYER : CI_SPLIT;
    const int cut = part ? lo + 9 * 128 * NWAVES : hi;
    conv_range(a, ws, layer, lo, cut, c128 * NWAVES + wave, 128 * NWAVES, lane, lds + wave * (64 * CT_PITCH));
    if (part && c128 >= 32) conv_range(a, ws, layer, cut, hi, (c128 - 32) * NWAVES + wave, 96 * NWAVES, lane, lds + wave * (64 * CT_PITCH));
}
__device__ __forceinline__ void prologue_phase(LAS unsigned char* lds, int wv) {
    int wave = wv, G = gridDim.x, bx = blockIdx.x; asm volatile("" : "+s"(wave), "+s"(G), "+s"(bx));
    int tid = TID_FROM(wave); asm volatile("" : "+v"(tid)); const int lane = tid & 63;
    const int vcu = (G % 8 == 0) ? (bx % 8) * (G / 8) + bx / 8 : bx;
    CArgs a = args_ptr(); unsigned char* ws = a->ws;
    const int gw = vcu * NWAVES + wave, NGW = G * NWAVES;
    conv_range(a, ws, 0, 0, CI_SPLIT, gw, NGW, lane, lds + wave * (64 * CT_PITCH));
    __syncthreads();
    for (int it = gw; it < DEPTH * 1024; it += NGW) {
        const int l = it >> 10, e = (it & 1023) * 256 + lane * 4;
        const f32x4 v = *(const f32x4*)(a->in[I_WPOOL] + (size_t)l * 262144 + e);
        u32x2 o; o.x = cvt_pk_bf16(v[0], v[1]); o.y = cvt_pk_bf16(v[2], v[3]);
        *(u32x2*)((bf16_t*)(ws + WS_W + (size_t)l * WL + WO_POOL) + e) = o;
    }
    for (int it = gw; it < DEPTH * M; it += NGW) {
        const int l = it / M, m = it % M;
        const float* src = m < MP ? a->in[I_PP] + ((size_t)l * MP + m) * PLE : a->in[I_PS] + ((size_t)l * MS + (m - MP)) * PLE;
        const f32x4 v = *(const f32x4*)(src + lane * 4);
        u32x2 o; o.x = cvt_pk_bf16(v[0], v[1]); o.y = cvt_pk_bf16(v[2], v[3]);
        *(u32x2*)((bf16_t*)(ws + WS_PB) + ((size_t)l * M + m) * PLE + lane * 4) = o;
    }
    for (int m = gw; m < M; m += NGW) {
        const float* src = m < MP ? a->in[I_XP] + (size_t)m * D : a->in[I_XS] + (size_t)(m - MP) * D;
        bf16_t* hb = (bf16_t*)(ws + WS_HB0) + (size_t)m * D;
        float s = 0.f;
#pragma unroll
        for (int j = 0; j < 8; ++j) { const f32x4 v = *(const f32x4*)(src + j * 256 + lane * 4);
            u32x2 o; o.x = cvt_pk_bf16(v[0], v[1]); o.y = cvt_pk_bf16(v[2], v[3]); *(u32x2*)(hb + j * 256 + lane * 4) = o;
            s += (v[0] * v[0] + v[1] * v[1]) + (v[2] * v[2] + v[3] * v[3]); }
        s += __shfl_xor(s, 32);
        if (lane < 32) ((float*)(ws + WS_SSQ))[(size_t)m * 32 + lane] = s;
    }
}

__device__ __forceinline__ float gelu_tanh(float x) {
    const float z = 1.5957691216057308f * (x + 0.044715f * x * x * x); return x * sigmoid_f(z);
}
struct SsmCtx {
    bf16x8 bfr[2][2];
    bf16x8 cfr[4];
    float lre, lim;
    float dv[4];
};
constexpr int S_PITCH = 136;
template <int MODE>
__device__ __forceinline__ void ssm_chunk(const SsmCtx& cx, const LAS unsigned char* ut, bf16_t* ya, int row0, int g, int lane, float& sre, float& sim, LAS bf16_t* simg,
                                          const float* st_in_re, const float* st_in_im, float* st_out_re, float* st_out_im) {
    const bf16x8 af = *(const LAS bf16x8*)(ut + 32 * (lane & 31) + 16 * (lane >> 5));
    u32x2 uw[2] = {};
    if (MODE != 0) {
#pragma unroll
        for (int tb = 0; tb < 2; ++tb) uw[tb] = *(const LAS u32x2*)(ut + 32 * (16 * tb + (lane & 15)) + 8 * (lane >> 4));
    }
    f32x16 xr0 = {}, xr1 = {}, xi0 = {}, xi1 = {};
    xr0 = __builtin_amdgcn_mfma_f32_32x32x16_bf16(af, cx.bfr[0][0], xr0, 0, 0, 0);
    xr1 = __builtin_amdgcn_mfma_f32_32x32x16_bf16(af, cx.bfr[0][1], xr1, 0, 0, 0);
    xi0 = __builtin_amdgcn_mfma_f32_32x32x16_bf16(af, cx.bfr[1][0], xi0, 0, 0, 0);
    xi1 = __builtin_amdgcn_mfma_f32_32x32x16_bf16(af, cx.bfr[1][1], xi1, 0, 0, 0);
    asm volatile("s_nop 15\n\ts_nop 15\n\ts_nop 15\n\ts_nop 15\n\ts_nop 15\n\ts_nop 15\n\ts_nop 15\n\ts_nop 15" : "+v"(xr0), "+v"(xr1), "+v"(xi0), "+v"(xi1));
#pragma unroll
    for (int r = 0; r < 16; ++r) {
        auto s1 = __builtin_amdgcn_permlane32_swap(__float_as_uint(xr0[r]), __float_as_uint(xr1[r]), false, false); xr0[r] = __uint_as_float(s1[0]); xr1[r] = __uint_as_float(s1[1]);
        auto s2 = __builtin_amdgcn_permlane32_swap(__float_as_uint(xi0[r]), __float_as_uint(xi1[r]), false, false); xi0[r] = __uint_as_float(s2[0]); xi1[r] = __uint_as_float(s2[1]);
    }
    float inr[4], ini[4];
    if (MODE == 2) {
#pragma unroll
        for (int q = 0; q < 4; ++q) { inr[q] = st_in_re[(size_t)q * NG * NP]; ini[q] = st_in_im[(size_t)q * NG * NP]; }
    }
#pragma unroll
    for (int t = 0; t < 32; ++t) {
        const int r = (t & 3) + 4 * (t >> 3); const bool hi = (t & 4) != 0;
        const float xr = hi ? xr1[r] : xr0[r], xi = hi ? xi1[r] : xi0[r];
        if (MODE == 2 && (t & 7) == 0) { sre = inr[t >> 3]; sim = ini[t >> 3]; }
        const float nr = __builtin_fmaf(cx.lre, sre, __builtin_fmaf(-cx.lim, sim, xr)), ni = __builtin_fmaf(cx.lre, sim, __builtin_fmaf(cx.lim, sre, xi));
        sre = nr; sim = ni;
        if (MODE != 0) *(LAS unsigned*)(simg + t * S_PITCH + 2 * lane) = cvt_pk_bf16(sre, sim);
        if (MODE == 2 && (t & 7) == 7) { st_out_re[(size_t)(t >> 3) * NG * NP] = sre; st_out_im[(size_t)(t >> 3) * NG * NP] = sim; }
    }
    if (MODE != 0) {
        LDS_WAIT(); asm volatile("" ::: "memory");
#pragma unroll
        for (int tb = 0; tb < 2; ++tb) {
            f32x4 y = {0.f, 0.f, 0.f, 0.f};
#pragma unroll
            for (int ks = 0; ks < 4; ++ks) { const bf16x8 sf = *(const LAS bf16x8*)(simg + (16 * tb + (lane & 15)) * S_PITCH + 32 * ks + 8 * (lane >> 4));
                y = __builtin_amdgcn_mfma_f32_16x16x32_bf16(cx.cfr[ks], sf, y, 0, 0, 0); }
            asm volatile("s_nop 15\n\ts_nop 15\n\ts_nop 15\n\ts_nop 15" : "+v"(y));
            const size_t o = (size_t)(row0 + 16 * tb + (lane & 15)) * SW + 16 * g + 4 * (lane >> 4);
            const float u0 = bf_lo(uw[tb].x), u1 = bf_hi(uw[tb].x), u2 = bf_lo(uw[tb].y), u3 = bf_hi(uw[tb].y);
            u32x2 ow; ow.x = cvt_pk_bf16(gelu_tanh(y[0] + cx.dv[0] * u0), gelu_tanh(y[1] + cx.dv[1] * u1)); ow.y = cvt_pk_bf16(gelu_tanh(y[2] + cx.dv[2] * u2), gelu_tanh(y[3] + cx.dv[3] * u3));
            *(u32x2*)(ya + o) = ow;
        }
        LDS_WAIT(); asm volatile("" ::: "memory");
    }
}

template <int W> __device__ __forceinline__ void pool_prompt(const bf16_t* base, bf16_t* mo, int t0) {
    unsigned z[W - 1 + 32];
#pragma unroll
    for (int i = 0; i < W - 1 + 32; ++i) { const int j = t0 - (W - 1) + i; z[i] = (i >= W - 1 || t0 > 0) ? *(const unsigned*)(base + (ptrdiff_t)j * PW) : 0u; }
    float r0 = 0.f, r1 = 0.f;
#pragma unroll
    for (int i = 0; i < W - 1; ++i) { r0 += bf_lo(z[i]); r1 += bf_hi(z[i]); }
#pragma unroll
    for (int t = 0; t < 32; ++t) {
        const float z0 = bf_lo(z[W - 1 + t]), z1 = bf_hi(z[W - 1 + t]), w0 = r0 + z0, w1 = r1 + z1;
        const float ic = (t + 1 < W) ? (t0 > 0 ? 1.0f / W : 1.0f / (t + 1)) : 1.0f / W;
        *(unsigned*)(mo + (size_t)t * PW) = cvt_pk_bf16(w0 * ic - z0, w1 * ic - z1);
        r0 = w0 - bf_lo(z[t]); r1 = w1 - bf_hi(z[t]);
    }
}
template <int W> __device__ __forceinline__ void pool_sample(const bf16_t* base, const float* prev, bf16_t* mo) {
    float h0[W - 1], h1[W - 1]; unsigned z[DS];
#pragma unroll
    for (int i = 0; i < W - 1; ++i) { const f32x2 v = *(const f32x2*)(prev + (size_t)(PBUF - (W - 1) + i) * PW); h0[i] = v.x; h1[i] = v.y; }
#pragma unroll
    for (int t = 0; t < DS; ++t) z[t] = *(const unsigned*)(base + (size_t)t * PW);
    float r0 = 0.f, r1 = 0.f;
#pragma unroll
    for (int i = 0; i < W - 1; ++i) { r0 += h0[i]; r1 += h1[i]; }
#pragma unroll
    for (int t = 0; t < DS; ++t) {
        const float z0 = bf_lo(z[t]), z1 = bf_hi(z[t]), w0 = r0 + z0, w1 = r1 + z1;
        *(unsigned*)(mo + (size_t)t * PW) = cvt_pk_bf16(w0 * (1.0f / W) - z0, w1 * (1.0f / W) - z1);
        const int jo = t - (W - 1);
        const float o0 = jo >= 0 ? bf_lo(z[jo >= 0 ? jo : 0]) : h0[jo < 0 ? t : 0], o1 = jo >= 0 ? bf_hi(z[jo >= 0 ? jo : 0]) : h1[jo < 0 ? t : 0];
        r0 = w0 - o0; r1 = w1 - o1;
    }
}
__device__ __forceinline__ void ssm_part(int layer, LAS unsigned char* lds, int wv) {
    int wave = wv, G = gridDim.x, bx = blockIdx.x; asm volatile("" : "+s"(wave), "+s"(G), "+s"(bx));
    int tid = TID_FROM(wave); asm volatile("" : "+v"(tid)); const int lane = tid & 63;
    CArgs a = args_ptr(); unsigned char* ws = a->ws;
    const bf16_t* ua = (const bf16_t*)(ws + WS_UA); const bf16_t* ub = (const bf16_t*)(ws + WS_UB);
    bf16_t* ya = (bf16_t*)(ws + WS_YA); bf16_t* mix = (bf16_t*)(ws + WS_MIX);
    LAS float* E = (LAS float*)lds;
    LAS bf16_t* simg = (LAS bf16_t*)(lds + 4096 + wave * (32 * S_PITCH * 2));
    LAS unsigned char* utile = lds + 4096 + NWAVES * (32 * S_PITCH * 2) + wave * 9216;
    static_assert(4096 + NWAVES * (32 * S_PITCH * 2) + NWAVES * 9216 <= LDSCTL_OFF, "S5 phase LDS map");
    for (int unit = 0; unit < 1; ++unit) {
        const int sq = (bx & 7) >> 1, g = ((bx >> 3) << 1) | (bx & 1);
        SsmCtx cx;
        {
            const float dt = expf(a->in[I_LDT][layer * NG + g]);
            const float are = a->in[I_ARE][((size_t)layer * NG + g) * NP + lane], aim = a->in[I_AIM][((size_t)layer * NG + g) * NP + lane];
            const float mag = expf(are * dt); float sn, cs; sincosf(aim * dt, &sn, &cs);
            cx.lre = mag * cs; cx.lim = mag * sn;
            const float den = are * are + aim * aim, nre = cx.lre - 1.0f;
            const float kre = (nre * are + cx.lim * aim) / den, kim = (cx.lim * are - nre * aim) / den;
#pragma unroll
            for (int q = 0; q < 2; ++q) {
                const int pp = 32 * q + (lane & 31); const float kr = __shfl(kre, pp), ki = __shfl(kim, pp);
                const size_t bo = (((size_t)layer * NG + g) * NP + pp) * NH + 8 * (lane >> 5);
                const f32x4 br0 = *(const f32x4*)(a->in[I_BRE] + bo), br1 = *(const f32x4*)(a->in[I_BRE] + bo + 4), bi0 = *(const f32x4*)(a->in[I_BIM] + bo), bi1 = *(const f32x4*)(a->in[I_BIM] + bo + 4);
                const u32x4 wre = pack8(br0 * kr - bi0 * ki, br1 * kr - bi1 * ki), wim = pack8(bi0 * kr + br0 * ki, bi1 * kr + br1 * ki);
                cx.bfr[0][q] = __builtin_bit_cast(bf16x8, wre); cx.bfr[1][q] = __builtin_bit_cast(bf16x8, wim);
            }
#pragma unroll
            for (int ks = 0; ks < 4; ++ks) {
                const int h = lane & 15, p0 = 16 * ks + 4 * (lane >> 4); const size_t co = (((size_t)layer * NG + g) * NH + h) * NP + p0;
                const f32x4 cr = *(const f32x4*)(a->in[I_CRE] + co), ci = *(const f32x4*)(a->in[I_CIM] + co);
                cx.cfr[ks] = __builtin_bit_cast(bf16x8, pack8((f32x4){cr[0], -ci[0], cr[1], -ci[1]}, (f32x4){cr[2], -ci[2], cr[3], -ci[3]}));
            }
#pragma unroll
            for (int i = 0; i < 4; ++i) cx.dv[i] = a->in[I_SD][((size_t)layer * NG + g) * NH + 4 * (lane >> 4) + i];
        }
        const int rowp = sq * SEQ + wave * 256, s0 = 32 * sq + 4 * wave;
        {
            bf16x8 tl[9];
#pragma unroll
            for (int c = 0; c < 9; ++c) tl[c] = *(const bf16x8*)(ua + (size_t)((c < 8 ? rowp + 32 * c : MP + s0 * DS) + (lane & 31)) * SW + 16 * g + 8 * (lane >> 5));
#pragma unroll
            for (int c = 0; c < 9; ++c) *(LAS bf16x8*)(utile + 1024 * c + 32 * (lane & 31) + 16 * (lane >> 5)) = tl[c];
            LDS_WAIT(); asm volatile("" ::: "memory");
        }
        float sre = 0.f, sim = 0.f;
        for (int c = 0; c < 8; ++c) ssm_chunk<0>(cx, utile + 1024 * c, ya, rowp + 32 * c, g, lane, sre, sim, simg, nullptr, nullptr, nullptr, nullptr);
        E[(wave * 64 + lane) * 2] = sre; E[(wave * 64 + lane) * 2 + 1] = sim;
        LDS_WAIT(); __syncthreads();
        float pr = cx.lre, pi = cx.lim;
#pragma unroll
        for (int i = 0; i < 8; ++i) { const float nr = pr * pr - pi * pi, ni = 2.f * pr * pi; pr = nr; pi = ni; }
        sre = 0.f; sim = 0.f;
        for (int v = 0; v < wave; ++v) { const float er = E[(v * 64 + lane) * 2], ei = E[(v * 64 + lane) * 2 + 1]; const float nr = pr * sre - pi * sim + er, ni = pr * sim + pi * sre + ei; sre = nr; sim = ni; }
        for (int c = 0; c < 8; ++c) ssm_chunk<1>(cx, utile + 1024 * c, ya, rowp + 32 * c, g, lane, sre, sim, simg, nullptr, nullptr, nullptr, nullptr);
        if (wave == 7) { a->out[O_SRP + (((size_t)layer * NB + sq) * NG + g) * NP + lane] = sre; a->out[O_SIP + (((size_t)layer * NB + sq) * NG + g) * NP + lane] = sim; }
        {
            const size_t so = (((size_t)layer * DB + s0) * NG + g) * NP + lane;
            float tr = 0.f, ti = 0.f;
            ssm_chunk<2>(cx, utile + 1024 * 8, ya, MP + s0 * DS, g, lane, tr, ti, simg, a->in[I_SRE] + so, a->in[I_SIM] + so, a->out + O_SRS + so, a->out + O_SIS + so);
        }
        __syncthreads();
    }
}
__device__ __forceinline__ void pool_part(int layer, int wv) {
    int wave = wv, G = gridDim.x, bx = blockIdx.x; asm volatile("" : "+s"(wave), "+s"(G), "+s"(bx));
    int tid = TID_FROM(wave); asm volatile("" : "+v"(tid)); const int lane = tid & 63;
    CArgs a = args_ptr(); unsigned char* ws = a->ws;
    const bf16_t* ua = (const bf16_t*)(ws + WS_UA); const bf16_t* ub = (const bf16_t*)(ws + WS_UB);
    bf16_t* ya = (bf16_t*)(ws + WS_YA); bf16_t* mix = (bf16_t*)(ws + WS_MIX);
    const int pair = (bx & 7) >> 1, pj = ((bx >> 3) << 1) | (bx & 1);
    const int gw = pj * NWAVES + wave, NGW = 64 * NWAVES;
    for (int it = gw; it < 64 * 8; it += NGW) {
        const int cb = it & 7, ts = (it >> 3) & 63, b = pair; const int c = cb * 128 + 2 * lane, t0 = ts * 32;
        const bf16_t* base = ub + (size_t)b * SEQ * PW + c; bf16_t* mo = mix + ((size_t)b * SEQ + t0) * PW + c;
        switch (cb >> 1) { case 0: pool_prompt<2>(base, mo, t0); break; case 1: pool_prompt<4>(base, mo, t0); break; case 2: pool_prompt<8>(base, mo, t0); break; default: pool_prompt<16>(base, mo, t0); break; }
    }
    for (int it = gw; it < 32 * 8; it += NGW) {
        const int cb = it & 7, b = 32 * pair + (it >> 3); const int c = cb * 128 + 2 * lane;
        const bf16_t* base = ub + ((size_t)MP + b * DS) * PW + c; const float* prev = a->in[I_SPOOL] + (((size_t)layer * DB + b) * PBUF) * PW + c; bf16_t* mo = mix + ((size_t)MP + b * DS) * PW + c;
        switch (cb >> 1) { case 0: pool_sample<2>(base, prev, mo); break; case 1: pool_sample<4>(base, prev, mo); break; case 2: pool_sample<8>(base, prev, mo); break; default: pool_sample<16>(base, prev, mo); break; }
    }
    const int gt = pj * NTHREADS + tid, NGT = 64 * NTHREADS;
    for (int e = gt; e < PBUF * (PW / 4); e += NGT) {
        const int c4 = e & 255, r = (e >> 8) % PBUF, b = pair;
        const u32x2 z = *(const u32x2*)(ub + ((size_t)b * SEQ + (SEQ - PBUF) + r) * PW + 4 * c4);
        *(f32x4*)(a->out + O_PP + (((size_t)layer * NB + b) * PBUF + r) * PW + 4 * c4) = (f32x4){bf_lo(z.x), bf_hi(z.x), bf_lo(z.y), bf_hi(z.y)};
    }
    for (int e = gt; e < 32 * PBUF * (PW / 4); e += NGT) {
        const int c4 = e & 255, r = (e >> 8) % PBUF, b = 32 * pair + (e >> 8) / PBUF; f32x4 v;
        if (r < PBUF - DS) v = *(const f32x4*)(a->in[I_SPOOL] + (((size_t)layer * DB + b) * PBUF + DS + r) * PW + 4 * c4);
        else { const u32x2 z = *(const u32x2*)(ub + ((size_t)MP + b * DS + (r - (PBUF - DS))) * PW + 4 * c4); v = (f32x4){bf_lo(z.x), bf_hi(z.x), bf_lo(z.y), bf_hi(z.y)}; }
        *(f32x4*)(a->out + O_PS + (((size_t)layer * DB + b) * PBUF + r) * PW + 4 * c4) = v;
    }
}

__device__ __forceinline__ void final_phase(int wv) {
    int wave = wv, G = gridDim.x, bx = blockIdx.x; asm volatile("" : "+s"(wave), "+s"(G), "+s"(bx));
    int tid = TID_FROM(wave); asm volatile("" : "+v"(tid)); const int lane = tid & 63;
    CArgs a = args_ptr(); const float* h = (const float*)(a->ws + WS_H); const float* ssq = (const float*)(a->ws + WS_SSQ);
    const int pair = (bx & 7) >> 1, pj = ((bx >> 3) << 1) | (bx & 1);
    const int gw = pj * NWAVES + wave, NGW = 64 * NWAVES;
    for (int r = gw; r < SEQ + 32 * DS; r += NGW) {
        const int m = r < SEQ ? pair * SEQ + r : MP + pair * (32 * DS) + (r - SEQ);
        const float s = wave_sum(lane < 32 ? ssq[(size_t)m * 32 + lane] : 0.f);
        const float rs = __builtin_amdgcn_rsqf(s * (1.0f / D) + RMS_EPS);
#pragma unroll
        for (int j = 0; j < 8; ++j) { const f32x4 v = *(const f32x4*)(h + (size_t)m * D + j * 256 + lane * 4), gn = *(const f32x4*)(a->in[I_GFIN] + j * 256 + lane * 4);
            *(f32x4*)(a->out + O_Y + (size_t)m * D + j * 256 + lane * 4) = v * rs * gn; }
    }
}

constexpr int PH_PER_LAYER = 10, PH_LAYER0 = 2, PH_FINAL = PH_LAYER0 + DEPTH * PH_PER_LAYER, N_PHASES = PH_FINAL + 1;

__global__ void __launch_bounds__(NTHREADS, 2) fwd(Args args) {
    extern __shared__ __attribute__((aligned(16))) unsigned char lds_raw[];
    LAS unsigned char* lds = (LAS unsigned char*)lds_raw;
    volatile LAS unsigned* MISC = (volatile LAS unsigned*)(lds + MISC_OFF);
    const int tid = threadIdx.x; const int wave0 = __builtin_amdgcn_readfirstlane(tid >> 6);
    const int G0 = gridDim.x; const int bx0 = blockIdx.x;
    for (int u = tid; u < (LDS_BYTES - LDSCTL_OFF) / 4; u += NTHREADS) ((LAS unsigned*)(lds + LDSCTL_OFF))[u] = 0u;
    __syncthreads();
    const int lo = args.ph_lo, hi = args.ph_hi;
    XcdBarrier bar; bar.bar = (unsigned*)(args.ws + WS_CTL) + CW_BAR; bar.x = 0; bar.st = nullptr; bar.G = (unsigned)G0;
    XcdBarrier gbar = bar, pbar = bar;
    if (hi - lo > 1) { bar = xcd_barrier_post((unsigned*)(args.ws + WS_CTL) + CW_BAR, MISC + 8, tid == 0, (unsigned)G0);
        gbar = xcd_barrier_post((unsigned*)(args.ws + WS_CTL) + 4096 * (1 + (bx0 & 7)), MISC + 10, tid == 0, (unsigned)(G0 / 8));
        pbar = xcd_barrier_post((unsigned*)(args.ws + WS_CTL) + 4096 * (9 + ((bx0 & 7) >> 1)), MISC + 12, tid == 0, (unsigned)(G0 / 4)); }
#define EVT(e) ((unsigned*)(args_ptr()->ws + WS_CTL) + 4096 * 13 + 64 * (e))
#define EVT_TMO ((unsigned*)(args_ptr()->ws + WS_CTL) + CW_BAR + XB_TMO)
#define IN(k) (lo <= (k) && (k) < hi)
#define SEAM(k) do { if (IN((k) + 1)) xcd_barrier(bar, TID_FROM(wave0) == 0); } while (0)
#define SEAML(k) do { if (IN((k) + 1)) xcd_barrier(gbar, TID_FROM(wave0) == 0); } while (0)
#define SEAMP(k) do { if (IN((k) + 1)) xcd_barrier(pbar, TID_FROM(wave0) == 0); } while (0)
#define WSP() unsigned char* ws = args_ptr()->ws; int G = G0, bx = bx0; asm volatile("" : "+s"(G), "+s"(bx))

    if (IN(0)) { prologue_phase(lds, wave0); SEAM(1); }
    for (int layer = 0; layer < DEPTH; ++layer) {
        const int pb = PH_LAYER0 + layer * PH_PER_LAYER;
#define LAYER_PTRS() WSP(); unsigned char* wl = ws + WS_W + (size_t)layer * WL; float* H = (float*)(ws + WS_H); \
        bf16_t* hb_cur = (bf16_t*)(ws + ((layer & 1) ? WS_HB1 : WS_HB0)); bf16_t* hb_nxt = (bf16_t*)(ws + ((layer & 1) ? WS_HB0 : WS_HB1)); \
        float* ssq0 = (float*)(ws + WS_SSQ); float* ssq1 = ssq0 + (size_t)M * 32; bf16_t* act = (bf16_t*)(ws + WS_ACT); \
        (void)wl; (void)H; (void)hb_cur; (void)hb_nxt; (void)ssq0; (void)ssq1; (void)act
        if (IN(pb + 0)) { if (layer > 0 && hi - lo > 1) evt_wait(EVT(2 * layer), 128u, EVT_TMO, TID_FROM(wave0) == 0);
            LAYER_PTRS();
            pg8::Gemm g{hb_cur, (const bf16_t*)(wl + WO_GU1), D, D, D, ws}; pg8::StaticOrder S; S.init(MP, 2 * FF, D, D, G, bx);
            EpiGateUp E{act, ssq0}; pg8::gemm_phase<EpiGateUp, pg8::StaticOrder, true, BarPre>(lds, g, S, E, wave0, BarPre{gbar, layer > 0 && IN(pb - 1), TID_FROM(wave0) == 0});
            if (bx >= 128) { deferred_convert(layer, 1, bx - 128, wave0, lds); __syncthreads(); if (hi - lo > 1) evt_arrive_wt(EVT(2 * layer + 1), TID_FROM(wave0) == 0); }
            if (bx >= 128 && bx < 160) {
                pg8::Gemm g2{(const bf16_t*)(wl + WO_PU), (const bf16_t*)(wl + WO_POOL), PW, 256, 256, ws}; WeffOrder S2{bx - 128}; EpiWeff E2{(bf16_t*)(wl + WO_EFF)};
                pg8::gemm_phase<EpiWeff, WeffOrder, false>(lds, g2, S2, E2, wave0);
                if (hi - lo > 1) evt_arrive(EVT(8 + layer), TID_FROM(wave0) == 0);
            }
        }
        if (IN(pb + 1)) { LAYER_PTRS();
            pg8::Gemm g{act, (const bf16_t*)(wl + WO_D1), FF, FF, FF, ws}; pg8::StaticOrder S; S.init(MP, D, FF, FF, G, bx);
            EpiResid E{H, hb_cur, ssq1, 0.5f, layer == 0 ? args_ptr()->in[I_XP] : H, layer == 0 ? args_ptr()->in[I_XS] : H + (size_t)MP * D};
            pg8::gemm_phase<EpiResid, pg8::StaticOrder, true, BarPre>(lds, g, S, E, wave0, BarPre{gbar, IN(pb + 0), TID_FROM(wave0) == 0});
        }
        if (IN(pb + 2)) { LAYER_PTRS();
            pg8::Gemm g{hb_cur, (const bf16_t*)(wl + WO_IN), D, D, D, ws}; pg8::StaticOrder S; S.init(MP, NIN, D, D, G, bx);
            EpiWin E{(bf16_t*)(ws + WS_UA), (bf16_t*)(ws + WS_UB), (bf16_t*)(ws + WS_SGA), (bf16_t*)(ws + WS_SGB), ssq1};
            pg8::gemm_phase<EpiWin, pg8::StaticOrder, true, BarPre>(lds, g, S, E, wave0, BarPre{gbar, IN(pb + 1), TID_FROM(wave0) == 0}); SEAMP(pb + 2);
        }
        if (IN(pb + 3)) { ssm_part(layer, lds, wave0); pool_part(layer, wave0);
            if (IN(pb + 4) && hi - lo > 1) { evt_poll(EVT(2 * layer + 1), 128u, EVT_TMO, TID_FROM(wave0) == 0); evt_poll(EVT(8 + layer), 32u, EVT_TMO, TID_FROM(wave0) == 0); }
            SEAMP(pb + 3); }
        if (IN(pb + 4) && !IN(pb + 3) && hi - lo > 1) { evt_wait(EVT(2 * layer + 1), 128u, EVT_TMO, TID_FROM(wave0) == 0); evt_wait(EVT(8 + layer), 32u, EVT_TMO, TID_FROM(wave0) == 0); }
        if (IN(pb + 4)) {
            { LAYER_PTRS(); pg8::Gemm g{(const bf16_t*)(ws + WS_YA), (const bf16_t*)(wl + WO_GLU), SW, SW, SW, ws}; GluOrder S; S.base.init(MP, D, SW, SW, G, bx);
              EpiGlu E{(const bf16_t*)(ws + WS_SGA), (bf16_t*)(ws + WS_PART)}; pg8::gemm_phase<EpiGlu, GluOrder, true>(lds, g, S, E, wave0); }
            { LAYER_PTRS(); pg8::Gemm g{(const bf16_t*)(ws + WS_MIX), (const bf16_t*)(wl + WO_EFF), PW, PW, PW, ws}; pg8::StaticOrder S; S.init(MP, D, PW, PW, G, bx);
              EpiPoolUp E{(const bf16_t*)(ws + WS_SGB), (const bf16_t*)(ws + WS_PART), (bf16_t*)(ws + WS_MRG)}; pg8::gemm_phase<EpiPoolUp, pg8::StaticOrder, true>(lds, g, S, E, wave0); }
        }
        if (IN(pb + 6)) { LAYER_PTRS();
            pg8::Gemm g{(const bf16_t*)(ws + WS_MRG), (const bf16_t*)(wl + WO_OUT), D, D, D, ws}; pg8::StaticOrder S; S.init(MP, D, D, D, G, bx);
            EpiResid E{H, hb_cur, ssq0, 1.0f, H, H + (size_t)MP * D}; pg8::gemm_phase<EpiResid, pg8::StaticOrder, true, BarPre>(lds, g, S, E, wave0, BarPre{gbar, IN(pb + 4), TID_FROM(wave0) == 0});
        }
        if (IN(pb + 7)) { LAYER_PTRS();
            pg8::Gemm g{hb_cur, (const bf16_t*)(wl + WO_GU2), D, D, D, ws}; pg8::StaticOrder S; S.init(MP, 2 * FF, D, D, G, bx);
            EpiGateUp E{act, ssq0}; pg8::gemm_phase<EpiGateUp, pg8::StaticOrder, true, BarPre>(lds, g, S, E, wave0, BarPre{gbar, IN(pb + 6), TID_FROM(wave0) == 0});
            if (bx >= 128) { deferred_convert(layer + 1, 0, bx - 128, wave0, lds); if (layer + 1 < DEPTH && hi - lo > 1) evt_arrive_wt(EVT(2 * (layer + 1)), TID_FROM(wave0) == 0); }
        }
        if (IN(pb + 8)) { LAYER_PTRS();
            pg8::Gemm g{act, (const bf16_t*)(wl + WO_D2), FF, FF, FF, ws}; pg8::StaticOrder S; S.init(MP, D, FF, FF, G, bx);
            EpiResid E{H, hb_cur, ssq1, 0.5f, H, H + (size_t)MP * D}; pg8::gemm_phase<EpiResid, pg8::StaticOrder, true, BarPre>(lds, g, S, E, wave0, BarPre{gbar, IN(pb + 7), TID_FROM(wave0) == 0});
        }
        if (IN(pb + 9)) {
            { LAYER_PTRS(); pg8::Gemm g{(const bf16_t*)(ws + WS_PB) + (size_t)layer * M * PLE, (const bf16_t*)(wl + WO_PLE), PLE, PLE, PLE, ws}; pg8::StaticOrder S; S.init(MP, D, PLE, PLE, G, bx);
              EpiStore E{(bf16_t*)(ws + WS_T1), D}; pg8::gemm_phase<EpiStore, pg8::StaticOrder, true, BarPre>(lds, g, S, E, wave0, BarPre{gbar, IN(pb + 8), TID_FROM(wave0) == 0}); }
            { LAYER_PTRS(); pg8::Gemm g{hb_cur, (const bf16_t*)(wl + WO_PG), D, D, D, ws}; pg8::StaticOrder S; S.init(MP, D, D, D, G, bx);
              EpiPle E{H, (const bf16_t*)(ws + WS_T1), layer + 1 < DEPTH ? hb_nxt : nullptr, ssq1, ssq0}; pg8::gemm_phase<EpiPle, pg8::StaticOrder, true>(lds, g, S, E, wave0); }
            if (layer + 1 == DEPTH) SEAMP(pb + 9);
        }
    }
    if (IN(PH_FINAL)) final_phase(wave0);
#undef IN
#undef SEAM
#undef SEAML
#undef SEAMP
}

extern "C" void kernel_launch(void* const* d_in, const int* in_sizes, int n_in, void* d_out, int out_size, void* d_ws, size_t ws_size, hipStream_t stream) {
    static int grid = 0;
    if (grid == 0) {
        if (n_in != N_IN || (size_t)out_size != O_END || ws_size < WS_END) { fprintf(stderr, "kernel_launch: unexpected shapes: n_in %d out %d ws %zu (need %zu)\n", n_in, out_size, ws_size, (size_t)WS_END); grid = -1; return; }
        int dev = 0, cus = 0, per_cu = 0;
        if (hipGetDevice(&dev) != hipSuccess || hipDeviceGetAttribute(&cus, hipDeviceAttributeMultiprocessorCount, dev) != hipSuccess) { grid = -1; return; }
        if (hipFuncSetAttribute((const void*)fwd, hipFuncAttributeMaxDynamicSharedMemorySize, LDS_BYTES) != hipSuccess) { fprintf(stderr, "kernel_launch: hipFuncSetAttribute failed\n"); grid = -1; return; }
        if (hipOccupancyMaxActiveBlocksPerMultiprocessor(&per_cu, (const void*)fwd, NTHREADS, LDS_BYTES) != hipSuccess || per_cu < 1) fprintf(stderr, "kernel_launch: occupancy query reports %d\n", per_cu);
        (void)hipGetLastError();
        if (cus < 256) { fprintf(stderr, "kernel_launch: built for a 256-CU device (one resident workgroup per CU), found %d CUs; nothing launched\n", cus); grid = -1; return; }
        grid = 256;
    }
    if (grid < 0) return;
    (void)hipMemsetAsync((char*)d_ws + WS_CTL, 0, CTL_ZERO_BYTES, stream);
    Args a{};
    for (int i = 0; i < N_IN; ++i) a.in[i] = (const float*)d_in[i];
    a.out = (float*)d_out; a.ws = (unsigned char*)d_ws;
#if MK_ONE_LAUNCH
    a.ph_lo = 0; a.ph_hi = N_PHASES;
    hipLaunchKernelGGL(fwd, dim3(grid), dim3(NTHREADS), LDS_BYTES, stream, a);
#else
    for (int p = 0; p < N_PHASES; ++p) { a.ph_lo = p; a.ph_hi = p + 1; hipLaunchKernelGGL(fwd, dim3(grid), dim3(NTHREADS), LDS_BYTES, stream, a); }
#endif
    const hipError_t le = hipPeekAtLastError();
    if (le != hipSuccess) fprintf(stderr, "kernel_launch: launch failed: %s\n", hipGetErrorName(le));
}
```
